# Optimizing an MI355X kernel written in HIP

```python
import math, functools
import jax, jax.numpy as jnp
from jax import lax
import numpy as np

D_MODEL = 1024
BATCH = 32
SEQ = 2048
DEPTH = 4

GRID_W = 64
CTX_LEN = 256
N_MIXERS = 3
CONF_KERNEL = 31
CONF_INNER = D_MODEL
SC_KERNEL = 3
S5_GROUP = 16
S5_GROUPS = D_MODEL // S5_GROUP
S5_STATE = 64
S5_DT_MIN = 1e-3
S5_DT_MAX = 1e-1
N_GROUPS = 4
EXPERTS_PER_GROUP = 8
N_EXPERTS = N_GROUPS * EXPERTS_PER_GROUP
TOP_K_IN_GROUP = 2
D_EXPERT = D_MODEL // 2
RMS_EPS = 1e-6
LN_EPS = 1e-5

kernel_name = 'hybrid_conv_s5_hmoe_diffusion_trunk'

F32 = jnp.float32


def _rmsnorm(x, g):
    xf = x.astype(F32)
    y = xf * lax.rsqrt(jnp.mean(xf * xf, axis=-1, keepdims=True) + RMS_EPS)
    return (y * g.astype(F32)).astype(x.dtype)


def _layernorm(x, g, b):
    xf = x.astype(F32)
    mu = jnp.mean(xf, axis=-1, keepdims=True)
    var = jnp.mean(jnp.square(xf - mu), axis=-1, keepdims=True)
    y = (xf - mu) * lax.rsqrt(var + LN_EPS)
    return (y * g.astype(F32) + b.astype(F32)).astype(x.dtype)


def _dwconv_grid(x, w):
    kh, kw, ch = w.shape
    return lax.conv_general_dilated(
        x, w.astype(x.dtype)[:, :, None, :], (1, 1),
        ((kh // 2, kh // 2), (kw // 2, kw // 2)),
        dimension_numbers=('NHWC', 'HWIO', 'NHWC'), feature_group_count=ch)


def _conv_latent(z, w):
    b, s, ch = z.shape
    rows = s // GRID_W
    y = _dwconv_grid(z.reshape(b, rows, GRID_W, ch), w)
    return y.reshape(b, s, ch)


def _conv_context(z, w1d):
    b, l, ch = z.shape
    y = _dwconv_grid(z.reshape(b, l, 1, ch), w1d[:, None, :])
    return y.reshape(b, l, ch)


def _conformer_module(h, conv_fn, w_in, dw_b, ln_g, ln_b, w_out):
    val, gate = jnp.split(h @ w_in, 2, axis=-1)
    z = val * jax.nn.sigmoid(gate)
    z = conv_fn(z) + dw_b
    z = _layernorm(z, ln_g, ln_b)
    return jax.nn.silu(z) @ w_out


def _short_conv_mixer(h, conv_fn, w_in, w_out):
    gb, gc, v = jnp.split(h @ w_in, 3, axis=-1)
    return (gb * conv_fn(gc * v)) @ w_out


def _s5_discretize(a_re, a_im, log_dt, b_re, b_im):
    a_re = jnp.minimum(a_re.astype(F32), -1e-4)
    a_im = a_im.astype(F32)
    dt = jnp.exp(log_dt.astype(F32))[:, None]
    mag = jnp.exp(dt * a_re)
    ang = dt * a_im
    abar_re = mag * jnp.cos(ang)
    abar_im = mag * jnp.sin(ang)
    den = a_re * a_re + a_im * a_im
    n_re = abar_re - 1.0
    n_im = abar_im
    k_re = (n_re * a_re + n_im * a_im) / den
    k_im = (n_im * a_re - n_re * a_im) / den
    b_re = b_re.astype(F32)
    b_im = b_im.astype(F32)
    bb_re = k_re[..., None] * b_re - k_im[..., None] * b_im
    bb_im = k_re[..., None] * b_im + k_im[..., None] * b_re
    return abar_re, abar_im, bb_re, bb_im


def _complex_linear_scan(abar_re, abar_im, bu_re, bu_im, reverse):
    length = bu_re.shape[1]
    a_re = jnp.broadcast_to(abar_re, (1, length) + abar_re.shape)
    a_im = jnp.broadcast_to(abar_im, (1, length) + abar_im.shape)

    def combine(e1, e2):
        a1r, a1i, b1r, b1i = e1
        a2r, a2i, b2r, b2i = e2
        return (a2r * a1r - a2i * a1i,
                a2r * a1i + a2i * a1r,
                a2r * b1r - a2i * b1i + b2r,
                a2r * b1i + a2i * b1r + b2i)

    _, _, hr, hi = lax.associative_scan(combine, (a_re, a_im, bu_re, bu_im),
                                        reverse=reverse, axis=1)
    return hr, hi


def _s5_states(u_g, disc, h0, reverse):
    abar_re, abar_im, bb_re, bb_im = disc
    bu_re = jnp.einsum('blgc,gpc->blgp', u_g, bb_re)
    bu_im = jnp.einsum('blgc,gpc->blgp', u_g, bb_im)
    if h0 is not None:
        h0r, h0i = h0
        pos = -1 if reverse else 0
        bu_re = bu_re.at[:, pos].add(abar_re * h0r - abar_im * h0i)
        bu_im = bu_im.at[:, pos].add(abar_re * h0i + abar_im * h0r)
    return _complex_linear_scan(abar_re, abar_im, bu_re, bu_im, reverse)


def _s5_readout(hr, hi, c_re, c_im):
    return (jnp.einsum('blgp,gcp->blgc', hr, c_re.astype(F32))
            - jnp.einsum('blgp,gcp->blgc', hi, c_im.astype(F32)))


def _s5_head(y, h, d, w_glu):
    b, l, dm = h.shape
    y = y.reshape(b, l, dm) + d.astype(F32) * h.astype(F32)
    y = jax.nn.gelu(y).astype(h.dtype)
    val, gate = jnp.split(y @ w_glu, 2, axis=-1)
    return val * jax.nn.sigmoid(gate)


def _s5_mixer(h_lat, h_ctx, a_re, a_im, log_dt, b_re, b_im, c_re, c_im, d, w_glu, need_ctx_out):
    def groups(h):
        b, l, _ = h.shape
        return h.astype(F32).reshape(b, l, S5_GROUPS, S5_GROUP)
    u_lat = groups(h_lat)
    u_ctx = groups(h_ctx)
    y_lat = 0.0
    y_ctx = 0.0
    for direction, reverse in enumerate((False, True)):
        disc = _s5_discretize(a_re[direction], a_im[direction], log_dt[direction],
                              b_re[direction], b_im[direction])
        cr, ci = _s5_states(u_ctx, disc, None, reverse)
        fin = (cr[:, 0], ci[:, 0]) if reverse else (cr[:, -1], ci[:, -1])
        if need_ctx_out:
            y_ctx = y_ctx + _s5_readout(cr, ci, c_re[direction], c_im[direction])
        lr, li = _s5_states(u_lat, disc, fin, reverse)
        y_lat = y_lat + _s5_readout(lr, li, c_re[direction], c_im[direction])
    out_lat = _s5_head(y_lat, h_lat, d, w_glu)
    out_ctx = _s5_head(y_ctx, h_ctx, d, w_glu) if need_ctx_out else None
    return out_lat, out_ctx


def _hier_moe(h, wg, bg, we, be, w13, w2):
    pg = jax.nn.softmax((h @ wg + bg).astype(F32), axis=-1)
    g_w, g_idx = lax.top_k(pg, 1)
    le = (h @ we + be).astype(F32).reshape(-1, N_GROUPS, EXPERTS_PER_GROUP)
    le = jnp.take_along_axis(le, g_idx[:, :, None], axis=1)[:, 0]
    pe = jax.nn.softmax(le, axis=-1)
    top_p, top_i = lax.top_k(pe, TOP_K_IN_GROUP)
    w = g_w * top_p / jnp.sum(top_p, axis=-1, keepdims=True)
    ids = g_idx * EXPERTS_PER_GROUP + top_i
    combine = jnp.sum(jax.nn.one_hot(ids, N_EXPERTS, dtype=F32) * w[..., None], axis=1)
    combine = combine.astype(h.dtype)
    y = jnp.zeros_like(h)
    for e in range(N_EXPERTS):
        a, g = jnp.split(h @ w13[e], 2, axis=-1)
        y = y + combine[:, e:e + 1] * ((jax.nn.silu(a) * g) @ w2[e])
    return y


def setup_inputs(seed: int = 0) -> dict:
    key = jax.random.key(seed)
    it = iter(list(jax.random.split(key, 40)))
    def nrm(shape, scale):
        return scale * jax.random.normal(next(it), shape, F32)
    n_conf = len([i for i in range(DEPTH) if i % N_MIXERS == 0])
    n_sc = len([i for i in range(DEPTH) if i % N_MIXERS == 1])
    n_s5 = len([i for i in range(DEPTH) if i % N_MIXERS == 2])
    d = D_MODEL
    G, P, CG = S5_GROUPS, S5_STATE, S5_GROUP
    n_idx = jnp.arange(P, dtype=F32)
    return {
        'x': nrm((BATCH, SEQ, d), 1.0),
        'c': nrm((BATCH, d), 1.0),
        'ctx': nrm((BATCH, CTX_LEN, d), 1.0),
        'c_ctx': nrm((d,), 1.0),
        'ada_w': nrm((DEPTH, d, 6 * d), 0.5 * d ** -0.5),
        'ada_b': nrm((DEPTH, 6 * d), 0.02),
        'norm1_g': 1.0 + nrm((DEPTH, d), 0.02),
        'norm2_g': 1.0 + nrm((DEPTH, d), 0.02),
        'conf_w_in': nrm((n_conf, d, 2 * CONF_INNER), d ** -0.5),
        'conf_dw': nrm((n_conf, CONF_KERNEL, CONF_INNER), CONF_KERNEL ** -0.5),
        'conf_dw_b': nrm((n_conf, CONF_INNER), 0.02),
        'conf_ln_g': 1.0 + nrm((n_conf, CONF_INNER), 0.02),
        'conf_ln_b': nrm((n_conf, CONF_INNER), 0.02),
        'conf_w_out': nrm((n_conf, CONF_INNER, d), CONF_INNER ** -0.5),
        'sc_w_in': nrm((n_sc, d, 3 * d), d ** -0.5),
        'sc_conv': nrm((n_sc, SC_KERNEL, d), SC_KERNEL ** -0.5),
        'sc_w_out': nrm((n_sc, d, d), d ** -0.5),
        's5_a_re': -0.5 + nrm((n_s5, 2, G, P), 0.01),
        's5_a_im': math.pi * n_idx + nrm((n_s5, 2, G, P), 0.01),
        's5_log_dt': jax.random.uniform(next(it), (n_s5, 2, G), F32,
                                        math.log(S5_DT_MIN), math.log(S5_DT_MAX)),
        's5_b_re': nrm((n_s5, 2, G, P, CG), (2 * CG) ** -0.5),
        's5_b_im': nrm((n_s5, 2, G, P, CG), (2 * CG) ** -0.5),
        's5_c_re': nrm((n_s5, 2, G, CG, P), P ** -0.5),
        's5_c_im': nrm((n_s5, 2, G, CG, P), P ** -0.5),
        's5_d': nrm((n_s5, d), 1.0),
        's5_w_glu': nrm((n_s5, d, 2 * d), d ** -0.5),
        'moe_wg': nrm((DEPTH, d, N_GROUPS), d ** -0.5),
        'moe_bg': nrm((DEPTH, N_GROUPS), 0.01),
        'moe_we': nrm((DEPTH, d, N_EXPERTS), d ** -0.5),
        'moe_be': nrm((DEPTH, N_EXPERTS), 0.01),
        'moe_w13': nrm((DEPTH, N_EXPERTS, d, 2 * D_EXPERT), d ** -0.5),
        'moe_w2': nrm((DEPTH, N_EXPERTS, D_EXPERT, d), D_EXPERT ** -0.5),
        'final_g': 1.0 + nrm((d,), 0.02),
    }


def reference(x, c, ctx, c_ctx, ada_w, ada_b, norm1_g, norm2_g,
              conf_w_in, conf_dw, conf_dw_b, conf_ln_g, conf_ln_b, conf_w_out,
              sc_w_in, sc_conv, sc_w_out,
              s5_a_re, s5_a_im, s5_log_dt, s5_b_re, s5_b_im, s5_c_re, s5_c_im, s5_d, s5_w_glu,
              moe_wg, moe_bg, moe_we, moe_be, moe_w13, moe_w2, final_g):
    b, s, dm = x.shape
    lc = ctx.shape[1]
    silu_c = jax.nn.silu(c)
    silu_cc = jax.nn.silu(c_ctx)
    for i in range(DEPTH):
        kind = i % N_MIXERS
        j = i // N_MIXERS
        update_ctx = i < DEPTH - 1
        need_ctx_in = update_ctx or kind == 2
        sh1, sc1, g1, sh2, sc2, g2 = jnp.split((silu_c @ ada_w[i] + ada_b[i])[:, None, :], 6, axis=-1)
        csh1, csc1, cg1, csh2, csc2, cg2 = jnp.split(silu_cc @ ada_w[i] + ada_b[i], 6, axis=-1)

        hx = _rmsnorm(x, norm1_g[i]) * (1.0 + sc1) + sh1
        hc = _rmsnorm(ctx, norm1_g[i]) * (1.0 + csc1) + csh1 if need_ctx_in else None
        if kind == 0:
            args = (conf_w_in[j], conf_dw_b[j], conf_ln_g[j], conf_ln_b[j], conf_w_out[j])
            mx = _conformer_module(hx, functools.partial(_conv_latent, w=conf_dw[j][:, None, :]), *args)
            mc = (_conformer_module(hc, functools.partial(_conv_context, w1d=conf_dw[j]), *args)
                  if update_ctx else None)
        elif kind == 1:
            mx = _short_conv_mixer(hx, functools.partial(_conv_latent, w=sc_conv[j][None, :, :]),
                                   sc_w_in[j], sc_w_out[j])
            mc = (_short_conv_mixer(hc, functools.partial(_conv_context, w1d=sc_conv[j]),
                                    sc_w_in[j], sc_w_out[j]) if update_ctx else None)
        else:
            mx, mc = _s5_mixer(hx, hc, s5_a_re[j], s5_a_im[j], s5_log_dt[j], s5_b_re[j], s5_b_im[j],
                               s5_c_re[j], s5_c_im[j], s5_d[j], s5_w_glu[j], update_ctx)
        x = x + g1 * mx
        if update_ctx:
            ctx = ctx + cg1 * mc

        hx2 = _rmsnorm(x, norm2_g[i]) * (1.0 + sc2) + sh2
        moe_args = (moe_wg[i], moe_bg[i], moe_we[i], moe_be[i], moe_w13[i], moe_w2[i])
        if update_ctx:
            hc2 = _rmsnorm(ctx, norm2_g[i]) * (1.0 + csc2) + csh2
            tokens = jnp.concatenate([hx2.reshape(-1, dm), hc2.reshape(-1, dm)], axis=0)
            y = _hier_moe(tokens, *moe_args)
            n_lat = b * s
            x = x + g2 * y[:n_lat].reshape(b, s, dm)
            ctx = ctx + cg2 * y[n_lat:].reshape(b, lc, dm)
        else:
            x = x + g2 * _hier_moe(hx2.reshape(-1, dm), *moe_args).reshape(b, s, dm)
    return _rmsnorm(x, final_g)
```

```cpp
#include <hip/hip_runtime.h>
#include <cstdio>
#include <cstdint>

#ifndef MK_NAIVE
#define MK_NAIVE 0
#endif
#ifndef MK_ALIGN_EPI
#define MK_ALIGN_EPI 1
#endif
#ifndef MK_ONE_LAUNCH
#define MK_ONE_LAUNCH 1
#endif

#define LAS __attribute__((address_space(3)))
typedef unsigned short bf16_t;
typedef short bf16x8 __attribute__((ext_vector_type(8)));
typedef float f32x4 __attribute__((ext_vector_type(4)));
typedef float f32x2 __attribute__((ext_vector_type(2)));
typedef unsigned u32x4 __attribute__((ext_vector_type(4)));
typedef unsigned u32x2 __attribute__((ext_vector_type(2)));
typedef int i32x4 __attribute__((ext_vector_type(4)));

constexpr int D = 1024, NB = 32, SEQ = 2048, LCTX = 256, DEPTH = 4;
constexpr int T_LAT = NB * SEQ, T_CTX = NB * LCTX, T_ALL = T_LAT + T_CTX;
constexpr int NMOD = NB + 1, MODW = 6 * D;
constexpr int NBUCKET = 112, SLOTS_MAX = T_ALL + NBUCKET * 256;
constexpr int NCHUNK = T_ALL / 32;
constexpr int AGLD = 768;
constexpr int NWG = 256, NTHR = 512;

constexpr size_t al256(size_t x) { return (x + 255) & ~(size_t)255; }
constexpr size_t WS_CTL = 0;
constexpr size_t CTL_BYTES = 65536;
constexpr size_t WS_MOD = WS_CTL + CTL_BYTES;
constexpr size_t WS_MODG = al256(WS_MOD + (size_t)DEPTH * NMOD * MODW * 4);
constexpr size_t WS_A32 = al256(WS_MODG + (size_t)DEPTH * 2 * NMOD * D * 2);
constexpr size_t WS_X = al256(WS_A32 + 64 * 2 * 64 * 8);
constexpr size_t WS_H = al256(WS_X + (size_t)(T_ALL + 1) * D * 2);
constexpr size_t WS_T1 = al256(WS_H + (size_t)T_ALL * D * 2);
constexpr size_t T1_BYTES = (size_t)64 * NCHUNK * AGLD * 2;
constexpr size_t WS_T2 = al256(WS_T1 + T1_BYTES);
constexpr size_t T2_BYTES = (size_t)SLOTS_MAX * D * 2;
constexpr size_t WS_T3 = al256(WS_T2 + T2_BYTES);
constexpr size_t WS_TOK = al256(WS_T3 + (size_t)T_ALL * D * 2);
constexpr size_t WS_CNT = al256(WS_TOK + (size_t)T_ALL * 16);
constexpr size_t WS_PERM = al256(WS_CNT + 256 * NBUCKET * 4);
constexpr size_t WS_SLOTW = al256(WS_PERM + (size_t)SLOTS_MAX * 4);
constexpr size_t WS_TILE = al256(WS_SLOTW + (size_t)SLOTS_MAX * 8);
constexpr size_t WS_WCIN = al256(WS_TILE + 4096);
constexpr size_t WS_WCOUT = al256(WS_WCIN + (size_t)2 * 2048 * 1024 * 2);
constexpr size_t WS_WSIN = al256(WS_WCOUT + (size_t)2 * 1024 * 1024 * 2);
constexpr size_t WS_WSOUT = al256(WS_WSIN + (size_t)3072 * 1024 * 2);
constexpr size_t WS_WGLU = al256(WS_WSOUT + (size_t)1024 * 1024 * 2);
constexpr size_t WS_W13 = al256(WS_WGLU + (size_t)2048 * 1024 * 2);
constexpr size_t WS_W2 = al256(WS_W13 + (size_t)128 * 1024 * 1024 * 2);
constexpr size_t WS_S5WS = al256(WS_W2 + (size_t)128 * 1024 * 512 * 2);
constexpr size_t WS_S5WT = al256(WS_S5WS + (size_t)64 * 256 * 512 * 2);
constexpr size_t WS_END = al256(WS_S5WT + (size_t)64 * 512 * 768 * 2);
constexpr size_t CTL_QUEUE = 16384;
static_assert(T1_BYTES >= (size_t)SLOTS_MAX * D * 2 && T2_BYTES >= (size_t)64 * NCHUNK * 256 * 4, "aliases");

constexpr int LDS_SCRATCH = 147456;
constexpr int LDS_MISC = LDS_SCRATCH;
constexpr int LDS_BARW = LDS_SCRATCH + 4096;
constexpr int LDS_BYTES = LDS_SCRATCH + 4096 + 64;

__device__ __forceinline__ unsigned cvt_pk_bf16(float lo, float hi) { unsigned r; asm volatile("v_cvt_pk_bf16_f32 %0, %1, %2" : "=v"(r) : "v"(lo), "v"(hi)); return r; }
#ifndef MK_WT
#define MK_WT 1
#endif
__device__ __forceinline__ void st16(void* p, const u32x4& v) {
#if MK_WT
    asm volatile("global_store_dwordx4 %0, %1, off sc1\n\ts_nop 1" :: "v"(p), "v"(v));
#else
    *(u32x4*)p = v;
#endif
}
__device__ __forceinline__ void st16o(void* base, unsigned off, const u32x4& v) {
#if MK_WT
    asm volatile("global_store_dwordx4 %0, %1, %2 sc1\n\ts_nop 1" :: "v"(off), "v"(v), "s"(base));
#else
    *(u32x4*)((char*)base + off) = v;
#endif
}
__device__ __forceinline__ void st16f(void* p, const f32x4& v) {
#if MK_WT
    asm volatile("global_store_dwordx4 %0, %1, off sc1\n\ts_nop 1" :: "v"(p), "v"(v));
#else
    *(f32x4*)p = v;
#endif
}
__device__ __forceinline__ float bf_lo(unsigned u) { return __uint_as_float(u << 16); }
__device__ __forceinline__ float bf_hi(unsigned u) { return __uint_as_float(u & 0xffff0000u); }
__device__ __forceinline__ float fast_sigmoid(float x) { return __builtin_amdgcn_rcpf(1.0f + __expf(-x)); }
__device__ __forceinline__ float wave_allsum(float v) {
    v += __shfl_xor(v, 32); v += __shfl_xor(v, 16); v += __shfl_xor(v, 8); v += __shfl_xor(v, 4); v += __shfl_xor(v, 2); v += __shfl_xor(v, 1); return v; }
__device__ __forceinline__ void wave_sum4(float (&v)[4], int lane) {
    const bool u5 = (lane & 32) != 0, u4 = (lane & 16) != 0;
    float r0 = (u5 ? v[2] : v[0]) + __shfl_xor(u5 ? v[0] : v[2], 32), r1 = (u5 ? v[3] : v[1]) + __shfl_xor(u5 ? v[1] : v[3], 32);
    float s = (u4 ? r1 : r0) + __shfl_xor(u4 ? r0 : r1, 16);
    s += __shfl_xor(s, 8); s += __shfl_xor(s, 4); s += __shfl_xor(s, 2); s += __shfl_xor(s, 1);
#pragma unroll
    for (int i = 0; i < 4; ++i) v[i] = __int_as_float(__builtin_amdgcn_readlane(__float_as_int(s), 16 * i));
}
__device__ __forceinline__ void wave_sum8(float (&v)[8], int lane) {
    const bool u5 = (lane & 32) != 0, u4 = (lane & 16) != 0, u3 = (lane & 8) != 0;
    float a[4];
#pragma unroll
    for (int i = 0; i < 4; ++i) a[i] = (u5 ? v[4 + i] : v[i]) + __shfl_xor(u5 ? v[i] : v[4 + i], 32);
    float b0 = (u4 ? a[2] : a[0]) + __shfl_xor(u4 ? a[0] : a[2], 16), b1 = (u4 ? a[3] : a[1]) + __shfl_xor(u4 ? a[1] : a[3], 16);
    float s = (u3 ? b1 : b0) + __shfl_xor(u3 ? b0 : b1, 8);
    s += __shfl_xor(s, 4); s += __shfl_xor(s, 2); s += __shfl_xor(s, 1);
#pragma unroll
    for (int i = 0; i < 8; ++i) v[i] = __int_as_float(__builtin_amdgcn_readlane(__float_as_int(s), 8 * i));
}
__device__ __forceinline__ int modrow_of(int row) { return row < T_LAT ? (row >> 11) : NB; }

struct Frame { LAS unsigned char* lds; int tid, lane, wave, G, bid; };
__device__ __forceinline__ Frame phase_frame(LAS unsigned char* lds) {
    Frame F; int t = threadIdx.x; asm volatile("" : "+v"(t)); F.lds = lds; F.tid = t; F.lane = t & 63; F.wave = __builtin_amdgcn_readfirstlane(t >> 6); F.G = gridDim.x; F.bid = blockIdx.x; return F; }

#define XB_TMO      128
#define XB_XCNT(j)  (256  + 64 * (j))
#define XB_XSUB(j)  (1280 + 64 * (j))
#define XB_XGEN(j)  (2304 + 64 * (j))
#define XB_TOP      3328
#define XB_TOPGEN   3392
#define XCD_BAR_WORDS 3456
#define XB_SPIN_CAP (1u << 20)
__device__ __forceinline__ unsigned xb_ld(unsigned* p)              { return __hip_atomic_load(p, __ATOMIC_RELAXED, __HIP_MEMORY_SCOPE_AGENT); }
__device__ __forceinline__ unsigned xb_add(unsigned* p, unsigned v) { return __hip_atomic_fetch_add(p, v, __ATOMIC_RELAXED, __HIP_MEMORY_SCOPE_AGENT); }
__device__ __forceinline__ unsigned xb_xcc_id() { return (unsigned)__builtin_amdgcn_s_getreg((3 << 11) | 20) & 0xFu; }
#define XB_SPIN(cond, bar) do { unsigned _sp = 0; while (cond) { __builtin_amdgcn_s_sleep(1); \
    if ((++_sp & 255u) == 0u) { if (xb_ld(&(bar)[XB_TMO])) break; if (_sp > XB_SPIN_CAP) { atomicAdd(&(bar)[XB_TMO], 1u); break; } } } } while (0)
struct XcdBarrier { unsigned* bar; unsigned x; volatile LAS unsigned* st; };
__device__ __forceinline__ XcdBarrier xcd_barrier_post(unsigned* bar, volatile LAS unsigned* st) {
    XcdBarrier b; b.bar = bar; b.x = xb_xcc_id(); b.st = st;
    if (threadIdx.x == 0) (void)xb_add(&bar[XB_XCNT(b.x)], 1u);
    return b;
}
__device__ __forceinline__ void xcd_barrier_complete(unsigned* bar, unsigned x, unsigned& nloc, unsigned& nx) {
    const unsigned G = gridDim.x * gridDim.y * gridDim.z;
    unsigned sum, cnt, mine, sp = 0u;
    for (;;) {
        sum = 0u; cnt = 0u; mine = 0u;
#pragma unroll
        for (unsigned j = 0; j < 16; ++j) { const unsigned c = xb_ld(&bar[XB_XCNT(j)]); sum += c; cnt += (c > 0u) ? 1u : 0u; mine = (j == x) ? c : mine; }
        if (sum == G) break;
        __builtin_amdgcn_s_sleep(1);
        if ((++sp & 255u) == 0u) { if (xb_ld(&bar[XB_TMO])) break; if (sp > XB_SPIN_CAP) { atomicAdd(&bar[XB_TMO], 1u); break; } }
    }
    nloc = mine > 0u ? mine : 1u; nx = cnt > 0u ? cnt : 1u;
}
__device__ __forceinline__ void xcd_barrier(const XcdBarrier& b) {
    asm volatile("s_waitcnt vmcnt(0)" ::: "memory");
    __syncthreads();
    if (threadIdx.x == 0) {
        unsigned* bar = b.bar;
        __builtin_amdgcn_s_waitcnt(0);
        unsigned nloc = b.st[0], nx = b.st[1];
        if (nloc == 0u) { xcd_barrier_complete(bar, b.x, nloc, nx); b.st[0] = nloc; b.st[1] = nx; }
        const unsigned old = xb_add(&bar[XB_XSUB(b.x)], 1u);
        const unsigned gen = old / nloc;
        if (old + 1u == (gen + 1u) * nloc) {
            __builtin_amdgcn_fence(__ATOMIC_RELEASE, "agent");
            asm volatile("s_waitcnt vmcnt(0)" ::: "memory");
            const unsigned og = xb_add(&bar[XB_TOP], 1u);
            const unsigned tg = og / nx;
            if (og + 1u == (tg + 1u) * nx) xb_add(&bar[XB_TOPGEN], 1u);
            else XB_SPIN(xb_ld(&bar[XB_TOPGEN]) == tg, bar);
            __builtin_amdgcn_fence(__ATOMIC_ACQUIRE, "agent");
            xb_add(&bar[XB_XGEN(b.x)], 1u);
            asm volatile("s_waitcnt vmcnt(0)" ::: "memory");
        } else {
            XB_SPIN(xb_ld(&bar[XB_XGEN(b.x)]) == gen, bar);
            __builtin_amdgcn_fence(__ATOMIC_ACQUIRE, "agent");
            asm volatile("s_waitcnt vmcnt(0)" ::: "memory");
        }
    }
    __syncthreads();
}

namespace pg8 {
constexpr int BM = 256, BK = 64, HALF = 128, HTB = HALF * BK * 2, STAGE_BYTES = 8 * HTB, NXCD = 8, WGM = 8;
__host__ __device__ __forceinline__ int lds_byte(int r, int c) { const int st = (r >> 4) * 2 + (c >> 5), rr = r & 15, cc = c & 31, ob = rr * 64 + cc * 2; return st * 1024 + (ob ^ (((ob >> 9) & 1) << 5)); }
__host__ __device__ __forceinline__ void stage_rc(int b, int& R, int& C) { const int st = b / 1024, sb = b % 1024, swz = sb ^ (((sb >> 9) & 1) << 5); R = (st >> 1) * 16 + swz / 64; C = (st & 1) * 32 + (swz % 64) / 2; }
__host__ __device__ __forceinline__ int perm32(int rho) { const int n = rho >> 4, i = rho & 15; return 8 * (i >> 2) + 4 * n + (i & 3); }

struct Unit { int pm, pn, pb; const char* a; const char* b; const char* b1; };
struct GemmDesc { int lda, ldb, K, ksplit; };

#if MK_NAIVE
template <class Epi, class Sched>
__device__ __forceinline__ void gemm_phase(LAS unsigned char* lds, const GemmDesc g, const Sched& S, const Epi& E) {
    int tid_ = threadIdx.x; asm volatile("" : "+v"(tid_));
    const int tid = tid_, wid = tid >> 6, lane = tid & 63, wr = wid >> 2, wc = wid & 3, fr = lane & 15, fq = lane >> 4;
    const int nt = g.K / BK;
    LAS unsigned* As = (LAS unsigned*)lds;
    LAS unsigned* Bs = (LAS unsigned*)(lds + 256 * 33 * 4);
    Unit u;
    for (int ui = 0; S.next(ui, u); ++ui) {
        f32x4 acc[2][2][4][2];
#pragma unroll
        for (int a = 0; a < 2; ++a)
#pragma unroll
            for (int b = 0; b < 2; ++b)
#pragma unroll
                for (int m = 0; m < 4; ++m)
#pragma unroll
                    for (int n = 0; n < 2; ++n) acc[a][b][m][n] = (f32x4){0.f, 0.f, 0.f, 0.f};
#pragma unroll 1
        for (int kt = 0; kt < nt; ++kt) {
            __syncthreads();
            const char* bsrc = (kt < g.ksplit) ? u.b : u.b1;
#pragma unroll
            for (int i = 0; i < 4; ++i) {
                const int piece = tid + i * 512, r = piece >> 3, cq = piece & 7;
                size_t arow = r; if constexpr (Sched::GATHER) arow = S.row_of(u, r);
                const u32x4 va = *(const u32x4*)(u.a + (arow * g.lda) * 2 + (size_t)kt * 128 + cq * 16);
                const u32x4 vb = *(const u32x4*)(bsrc + ((size_t)r * g.ldb) * 2 + (size_t)kt * 128 + cq * 16);
                As[r * 33 + cq * 4 + 0] = va.x; As[r * 33 + cq * 4 + 1] = va.y; As[r * 33 + cq * 4 + 2] = va.z; As[r * 33 + cq * 4 + 3] = va.w;
                Bs[r * 33 + cq * 4 + 0] = vb.x; Bs[r * 33 + cq * 4 + 1] = vb.y; Bs[r * 33 + cq * 4 + 2] = vb.z; Bs[r * 33 + cq * 4 + 3] = vb.w;
            }
            __syncthreads();
#pragma unroll 1
            for (int k2 = 0; k2 < 32; ++k2) {
                float a0[2][4], a1[2][4];
#pragma unroll
                for (int ai = 0; ai < 2; ++ai)
#pragma unroll
                    for (int m = 0; m < 4; ++m) { const unsigned v = As[(ai * 128 + wr * 64 + m * 16 + fr) * 33 + k2]; a0[ai][m] = bf_lo(v); a1[ai][m] = bf_hi(v); }
#pragma unroll
                for (int bj = 0; bj < 2; ++bj)
#pragma unroll
                    for (int n = 0; n < 2; ++n)
#pragma unroll
                        for (int j = 0; j < 4; ++j) {
                            const unsigned v = Bs[(bj * 128 + wc * 32 + fq * 8 + n * 4 + j) * 33 + k2]; const float b0 = bf_lo(v), b1 = bf_hi(v);
#pragma unroll
                            for (int ai = 0; ai < 2; ++ai)
#pragma unroll
                                for (int m = 0; m < 4; ++m) acc[ai][bj][m][n][j] += a0[ai][m] * b0 + a1[ai][m] * b1;
                        }
            }
        }
        E(acc, u, wr, wc, fr, fq);
    }
    __syncthreads();
}
#else
template <class Epi, class Sched>
__device__ __forceinline__ void gemm_phase(LAS unsigned char* lds, const GemmDesc g, const Sched& S, const Epi& E) {
    int tid_ = threadIdx.x; asm volatile("" : "+v"(tid_));
    const int tid = tid_, wid = __builtin_amdgcn_readfirstlane(tid >> 6), lane = tid & 63, wr = wid >> 2, wc = wid & 3, fr = lane & 15, fq = lane >> 4;
    const int nt = g.K / BK, ksplit = g.ksplit;
    unsigned voffB[2]; int Rv[2], Cv[2];
#pragma unroll
    for (int i = 0; i < 2; ++i) { int R, C; stage_rc(tid * 16 + i * 8192, R, C); const int Rb = (R & ~31) + perm32(R & 31);
        Rv[i] = R; Cv[i] = C; voffB[i] = (unsigned)(Rb * g.ldb + C) * 2u; }
    unsigned va[2][2], vn[2][2];
#define PG8_SETV(v, un) do { _Pragma("unroll") for (int _h = 0; _h < 2; ++_h) _Pragma("unroll") for (int _i = 0; _i < 2; ++_i) { \
        if constexpr (Sched::GATHER) (v)[_h][_i] = (unsigned)S.row_of((un), _h * HALF + Rv[_i]) * (unsigned)(g.lda * 2) + (unsigned)(Cv[_i] * 2); \
        else (v)[_h][_i] = (unsigned)((_h * HALF + Rv[_i]) * g.lda + Cv[_i]) * 2u; } } while (0)
    const size_t kstep = (size_t)(BK * 2);
    const size_t hstepB = (size_t)HALF * g.ldb * 2;
    const unsigned ldsw = (unsigned)wid * 1024u;
    const int aoff = lds_byte(wr * 64 + fr, fq * 8), boff = lds_byte(wc * 32 + fr, fq * 8);
#define PG8_SA(b, h) (((b) * 2 + (h)) * HTB)
#define PG8_SB(b, h) ((4 + (b) * 2 + (h)) * HTB)
#define PG8_STAGE(bufoff, gbase, voff) do { _Pragma("unroll") for (int _i = 0; _i < 2; ++_i) \
        __builtin_amdgcn_global_load_lds((const unsigned*)((const char*)(gbase) + (voff)[_i]), (LAS unsigned*)(lds + (bufoff) + ldsw + _i * 8192), 16, 0, 0); } while (0)
#define PG8_STAGEA(bufoff, gbase, h, nx) do { _Pragma("unroll") for (int _i = 0; _i < 2; ++_i) { const unsigned _o = (nx) ? vn[h][_i] : va[h][_i]; \
        __builtin_amdgcn_global_load_lds((const unsigned*)((const char*)(gbase) + _o), (LAS unsigned*)(lds + (bufoff) + ldsw + _i * 8192), 16, 0, 0); } } while (0)
#define PG8_LDA(dst, b, h) do { _Pragma("unroll") for (int m = 0; m < 4; ++m) _Pragma("unroll") for (int k = 0; k < 2; ++k) dst[m][k] = *(const LAS bf16x8*)(lds + PG8_SA(b, h) + aoff + m * 2048 + k * 1024); } while (0)
#define PG8_LDB(dst, b, h) do { _Pragma("unroll") for (int n = 0; n < 2; ++n) _Pragma("unroll") for (int k = 0; k < 2; ++k) dst[n][k] = *(const LAS bf16x8*)(lds + PG8_SB(b, h) + boff + n * 2048 + k * 1024); } while (0)
#define PG8_MMA(ai, bj, At, Bt) do { __builtin_amdgcn_s_setprio(1); _Pragma("unroll") for (int m = 0; m < 4; ++m) _Pragma("unroll") for (int n = 0; n < 2; ++n) _Pragma("unroll") for (int k = 0; k < 2; ++k) \
        acc[ai][bj][m][n] = __builtin_amdgcn_mfma_f32_16x16x32_bf16(Bt[n][k], At[m][k], acc[ai][bj][m][n], 0, 0, 0); __builtin_amdgcn_s_setprio(0); } while (0)
#define PG8_WAIT_V(n) asm volatile("s_waitcnt vmcnt(" #n ")" ::: "memory")
#define PG8_WAIT_L(n) asm volatile("s_waitcnt lgkmcnt(" #n ")" ::: "memory")
#define PG8_BAR __builtin_amdgcn_s_barrier()
#define PG8_SCHED __builtin_amdgcn_sched_barrier(0)
    Unit cur, nxt; int ui = 0;
    if (!S.next(0, cur)) return;
    f32x4 acc[2][2][4][2];
#pragma unroll
    for (int a = 0; a < 2; ++a)
#pragma unroll
        for (int b = 0; b < 2; ++b)
#pragma unroll
            for (int m = 0; m < 4; ++m)
#pragma unroll
                for (int n = 0; n < 2; ++n) acc[a][b][m][n] = (f32x4){0.f, 0.f, 0.f, 0.f};
    bf16x8 At[4][2], B0[2][2], B1[2][2];
    const char* cA = cur.a; const char* cB = cur.b; const char* cB1 = cur.b1;
    PG8_SETV(va, cur);
#pragma unroll
    for (int _h = 0; _h < 2; ++_h)
#pragma unroll
        for (int _i = 0; _i < 2; ++_i) vn[_h][_i] = va[_h][_i];
    PG8_STAGE(PG8_SB(0, 0), cB, voffB); PG8_STAGE(PG8_SB(0, 1), cB + hstepB, voffB); PG8_STAGEA(PG8_SA(0, 0), cA, 0, false); PG8_STAGEA(PG8_SA(0, 1), cA, 1, false);
    if (wr == 1) PG8_BAR;
    PG8_WAIT_V(2); PG8_BAR;
    PG8_STAGE(PG8_SB(1, 0), cB + kstep, voffB); PG8_STAGEA(PG8_SA(1, 0), cA + kstep, 0, false); PG8_STAGE(PG8_SB(1, 1), cB + hstepB + kstep, voffB);
    PG8_WAIT_V(6); PG8_BAR;
    for (;;) {
        const bool has_next = S.next(ui + 1, nxt);
        const char* nA = has_next ? nxt.a : cA; const char* nB = has_next ? nxt.b : cB;
        if (has_next) { PG8_SETV(vn, nxt); }
        for (int t = 0; t < nt; t += 2) {
            const bool last = (t == nt - 2);
            const char* a1 = cA + (size_t)(t + 1) * kstep;
            const char* bsel = (t + 2 < ksplit) ? cB : cB1;
            const char* a2 = last ? nA : cA + (size_t)(t + 2) * kstep; const char* b2 = last ? nB : bsel + (size_t)(t + 2) * kstep;
            const char* a3 = a2 + kstep; const char* b3 = b2 + kstep;
            PG8_LDB(B0, 0, 0); PG8_LDB(B1, 0, 1); PG8_SCHED; PG8_LDA(At, 0, 0); PG8_STAGEA(PG8_SA(1, 1), a1, 1, false);
            PG8_WAIT_V(8); PG8_WAIT_L(0); PG8_BAR; PG8_MMA(0, 0, At, B0); PG8_MMA(0, 1, At, B1); PG8_BAR; PG8_SCHED;
            PG8_LDA(At, 0, 1); PG8_STAGE(PG8_SB(0, 0), b2, voffB); PG8_STAGE(PG8_SB(0, 1), b2 + hstepB, voffB); PG8_STAGEA(PG8_SA(0, 0), a2, 0, last);
            PG8_WAIT_V(8); PG8_WAIT_L(0); PG8_BAR; PG8_MMA(1, 0, At, B0); PG8_MMA(1, 1, At, B1); PG8_BAR; PG8_SCHED;
            PG8_LDB(B0, 1, 0); PG8_LDB(B1, 1, 1); PG8_SCHED; PG8_LDA(At, 1, 0); PG8_STAGEA(PG8_SA(0, 1), a2, 1, last);
            PG8_WAIT_V(8); PG8_WAIT_L(0); PG8_BAR; PG8_MMA(0, 0, At, B0); PG8_MMA(0, 1, At, B1); PG8_BAR; PG8_SCHED;
            PG8_LDA(At, 1, 1); PG8_STAGE(PG8_SB(1, 0), b3, voffB); PG8_STAGE(PG8_SB(1, 1), b3 + hstepB, voffB); PG8_STAGEA(PG8_SA(1, 0), a3, 0, last);
            PG8_WAIT_V(8); PG8_WAIT_L(0); PG8_BAR; PG8_MMA(1, 0, At, B0); PG8_MMA(1, 1, At, B1); PG8_BAR; PG8_SCHED;
        }
#if MK_ALIGN_EPI
        if (wr == 0) PG8_BAR;
#endif
        E(acc, cur, wr, wc, fr, fq);
        if (!has_next) break;
#pragma unroll
        for (int a = 0; a < 2; ++a)
#pragma unroll
            for (int b = 0; b < 2; ++b)
#pragma unroll
                for (int m = 0; m < 4; ++m)
#pragma unroll
                    for (int n = 0; n < 2; ++n) acc[a][b][m][n] = (f32x4){0.f, 0.f, 0.f, 0.f};
        cur = nxt; cA = nA; cB = nB; cB1 = nxt.b1; ++ui;
#pragma unroll
        for (int _h = 0; _h < 2; ++_h)
#pragma unroll
            for (int _i = 0; _i < 2; ++_i) va[_h][_i] = vn[_h][_i];
#if MK_ALIGN_EPI
        if (wr == 1) PG8_BAR;
#endif
    }
    PG8_WAIT_V(0);
#if !MK_ALIGN_EPI
    if (wr == 0) PG8_BAR;
#endif
    PG8_BAR;
#undef PG8_SA
#undef PG8_SB
#undef PG8_STAGE
#undef PG8_STAGEA
#undef PG8_SETV
#undef PG8_LDA
#undef PG8_LDB
#undef PG8_MMA
#undef PG8_WAIT_V
#undef PG8_WAIT_L
#undef PG8_BAR
#undef PG8_SCHED
}
#endif

struct DenseOrder {
    static constexpr bool GATHER = false;
    int same = 0;
    const char* A; const char* Bt; size_t strideA, strideB; int lda, ldb, nM, nN, nB, ntot, G, c;
    __device__ void init(const void* A_, const void* Bt_, int M, int N, int lda_, int ldb_, int nB_, size_t sA, size_t sB, int G_, int c_) {
        A = (const char*)A_; Bt = (const char*)Bt_; lda = lda_; ldb = ldb_; nM = M / BM; nN = N / BM; nB = nB_; ntot = nM * nN * nB; strideA = sA; strideB = sB; G = G_; c = c_; }
    __device__ __forceinline__ bool next(int i, Unit& u) const {
        const int L = i * G + c; if (L >= ntot) return false;
        int wgid = L; { const int q = ntot / NXCD, r = ntot % NXCD, xcd = wgid % NXCD, off = wgid / NXCD; wgid = (xcd < r ? xcd * (q + 1) : r * (q + 1) + (xcd - r) * q) + off; }
        const int per = nM * nN, pb = wgid / per, rem = wgid % per;
        const int nig = WGM * nN, gid = rem / nig, fm = gid * WGM, gsz = (nM - fm) < WGM ? (nM - fm) : WGM;
        u.pm = fm + ((rem % nig) % gsz); u.pn = (rem % nig) / gsz; u.pb = pb;
        u.a = A + (size_t)pb * strideA + (size_t)u.pm * BM * lda * 2; u.b = Bt + (size_t)pb * strideB + (size_t)u.pn * BM * ldb * 2; u.b1 = u.b;
        if (same) { u.a = A; u.b = Bt; u.b1 = Bt; }
        return true;
    }
};
template <int WHICH  > struct MoeOrder {
    static constexpr bool GATHER = (WHICH == 1);
    const char* A; const char* W; const LAS int* tile; const int* perm; int n_mt, nN, ntot, G, c;
    int dense = 0;
    __device__ __forceinline__ int row_of(const Unit& u, int r) const { if (dense == 1) return (u.pm * BM + r) % T_LAT; const int t = perm[u.pm * BM + r]; return t < 0 ? 0 : t; }
    __device__ void init(const void* A_, const void* W_, const LAS int* tile_, const int* perm_, int G_, int c_) {
        A = (const char*)A_; W = (const char*)W_; tile = tile_; perm = perm_; G = G_; c = c_;
        n_mt = __builtin_amdgcn_readfirstlane(tile[0]);
        nN = (WHICH == 1) ? 8 : 4; ntot = n_mt * nN; }
    __device__ __forceinline__ bool next(int i, Unit& u) const {
        const int L = i * G + c; if (L >= ntot) return false;
        int wgid = L; { const int q = ntot / NXCD, r = ntot % NXCD, xcd = wgid % NXCD, off = wgid / NXCD; wgid = (xcd < r ? xcd * (q + 1) : r * (q + 1) + (xcd - r) * q) + off; }
        const int mt = wgid / nN, pn = wgid % nN;
        const int ee = __builtin_amdgcn_readfirstlane(tile[16 + mt]);
        const int elo = ee & 255, ehi = (ee >> 8) & 255;
        u.pm = mt; u.pn = pn; u.pb = 0;
        u.a = (WHICH == 1) ? A : A + (size_t)mt * BM * D * 2;
        if (WHICH == 1) { const int e = dense == 2 ? 0 : ((pn < 4) ? elo : ehi); u.b = W + (size_t)e * 1024 * 1024 * 2 + (size_t)(pn & 3) * BM * 1024 * 2; u.b1 = u.b; }
        else { u.b = W + (size_t)elo * 1024 * 512 * 2 + (size_t)pn * BM * 512 * 2; u.b1 = W + (size_t)ehi * 1024 * 512 * 2 + (size_t)pn * BM * 512 * 2 - 8 * 128; }
        return true;
    }
};

#define EPI_ARGS const f32x4 (&acc)[2][2][4][2], const Unit& u, int wr, int wc, int fr, int fq
#define EPI_ROW(ai, m) (u.pm * BM + (ai) * HALF + wr * 64 + (m) * 16 + fr)
__device__ __forceinline__ u32x4 pack8(const f32x4& a, const f32x4& b) { u32x4 w; w.x = cvt_pk_bf16(a[0], a[1]); w.y = cvt_pk_bf16(a[2], a[3]); w.z = cvt_pk_bf16(b[0], b[1]); w.w = cvt_pk_bf16(b[2], b[3]); return w; }

struct EpiGlu { bf16_t* Z;
    __device__ __forceinline__ void operator()(EPI_ARGS) const {
        const int ch = u.pn * 128 + wc * 32 + fq * 8;
#pragma unroll
        for (int ai = 0; ai < 2; ++ai)
#pragma unroll
            for (int m = 0; m < 4; ++m) { f32x4 o[2];
#pragma unroll
                for (int n = 0; n < 2; ++n)
#pragma unroll
                    for (int j = 0; j < 4; ++j) o[n][j] = acc[ai][0][m][n][j] * fast_sigmoid(acc[ai][1][m][n][j]);
                st16(Z + (size_t)EPI_ROW(ai, m) * D + ch, pack8(o[0], o[1])); }
    }
};
__device__ __forceinline__ void unpack8(const u32x4& v, f32x4& a, f32x4& b) { a[0] = bf_lo(v.x); a[1] = bf_hi(v.x); a[2] = bf_lo(v.y); a[3] = bf_hi(v.y); b[0] = bf_lo(v.z); b[1] = bf_hi(v.z); b[2] = bf_lo(v.w); b[3] = bf_hi(v.w); }
template <bool F32SRC> struct EpiResid { const float* src_lat; const float* src_ctx_adj; bf16_t* X16; const bf16_t* gate16;
    __device__ __forceinline__ void operator()(EPI_ARGS) const {
        const int row0 = u.pm * BM; const float* src = (row0 < T_LAT) ? src_lat : src_ctx_adj; const bf16_t* gp = gate16 + (size_t)modrow_of(row0) * D;
        if (F32SRC) {
#pragma unroll
            for (int bj = 0; bj < 2; ++bj) { const int col = u.pn * BM + bj * HALF + wc * 32 + fq * 8;
                f32x4 g0, g1; unpack8(*(const u32x4*)(gp + col), g0, g1);
#pragma unroll
                for (int ai = 0; ai < 2; ++ai) { f32x4 x0[4], x1[4];
#pragma unroll
                    for (int m = 0; m < 4; ++m) { const size_t o = (size_t)EPI_ROW(ai, m) * D + col; x0[m] = *(const f32x4*)(src + o); x1[m] = *(const f32x4*)(src + o + 4); }
#pragma unroll
                    for (int m = 0; m < 4; ++m) st16o(X16, (unsigned)(EPI_ROW(ai, m) * D + col) * 2u, pack8(x0[m] + g0 * acc[ai][bj][m][0], x1[m] + g1 * acc[ai][bj][m][1])); } }
        } else { u32x4 xs[2][2][4], gg[2];
#pragma unroll
            for (int bj = 0; bj < 2; ++bj) { const int col = u.pn * BM + bj * HALF + wc * 32 + fq * 8; gg[bj] = *(const u32x4*)(gp + col);
#pragma unroll
                for (int ai = 0; ai < 2; ++ai)
#pragma unroll
                    for (int m = 0; m < 4; ++m) xs[bj][ai][m] = *(const u32x4*)(X16 + (size_t)EPI_ROW(ai, m) * D + col); }
#pragma unroll
            for (int bj = 0; bj < 2; ++bj) { const int col = u.pn * BM + bj * HALF + wc * 32 + fq * 8; f32x4 g0, g1; unpack8(gg[bj], g0, g1);
#pragma unroll
                for (int ai = 0; ai < 2; ++ai)
#pragma unroll
                    for (int m = 0; m < 4; ++m) { f32x4 x0, x1; unpack8(xs[bj][ai][m], x0, x1);
                        st16o(X16, (unsigned)(EPI_ROW(ai, m) * D + col) * 2u, pack8(x0 + g0 * acc[ai][bj][m][0], x1 + g1 * acc[ai][bj][m][1])); } } }
    }
};
struct EpiGluResid { bf16_t* X16; const bf16_t* gate16;
    __device__ __forceinline__ void operator()(EPI_ARGS) const {
        const int row0 = u.pm * BM; const int ch = u.pn * 128 + wc * 32 + fq * 8;
        const u32x4 gg = *(const u32x4*)(gate16 + (size_t)modrow_of(row0) * D + ch);
        u32x4 xs[2][4];
#pragma unroll
        for (int ai = 0; ai < 2; ++ai)
#pragma unroll
            for (int m = 0; m < 4; ++m) xs[ai][m] = *(const u32x4*)(X16 + (size_t)EPI_ROW(ai, m) * D + ch);
#pragma unroll
        for (int ai = 0; ai < 2; ++ai)
#pragma unroll
            for (int m = 0; m < 4; ++m) { f32x4 v[2], x0, x1, g0, g1;
                unpack8(xs[ai][m], x0, x1); unpack8(gg, g0, g1);
#pragma unroll
                for (int n = 0; n < 2; ++n)
#pragma unroll
                    for (int j = 0; j < 4; ++j) v[n][j] = acc[ai][0][m][n][j] * fast_sigmoid(acc[ai][1][m][n][j]);
                st16o(X16, (unsigned)(EPI_ROW(ai, m) * D + ch) * 2u, pack8(x0 + g0 * v[0], x1 + g1 * v[1])); }
    }
};
struct EpiSc { bf16_t* P; bf16_t* GB;
    __device__ __forceinline__ void operator()(EPI_ARGS) const {
        if (u.pn < 8) { const int ch = u.pn * 128 + wc * 32 + fq * 8;
#pragma unroll
            for (int ai = 0; ai < 2; ++ai)
#pragma unroll
                for (int m = 0; m < 4; ++m) st16(P + (size_t)EPI_ROW(ai, m) * D + ch, pack8(acc[ai][0][m][0] * acc[ai][1][m][0], acc[ai][0][m][1] * acc[ai][1][m][1]));
        } else {
#pragma unroll
            for (int bj = 0; bj < 2; ++bj) { const int ch = (u.pn - 8) * BM + bj * HALF + wc * 32 + fq * 8;
#pragma unroll
                for (int ai = 0; ai < 2; ++ai)
#pragma unroll
                    for (int m = 0; m < 4; ++m) st16(GB + (size_t)EPI_ROW(ai, m) * D + ch, pack8(acc[ai][bj][m][0], acc[ai][bj][m][1])); } }
    }
};
struct EpiSwiglu { bf16_t* ACT; const f32x2* slotw; int nolw = 0;
    __device__ __forceinline__ void operator()(EPI_ARGS) const {
        const int which = u.pn >> 2, ch = which * 512 + (u.pn & 3) * 128 + wc * 32 + fq * 8;
        float wv[2][4];
#pragma unroll
        for (int ai = 0; ai < 2; ++ai)
#pragma unroll
            for (int m = 0; m < 4; ++m) wv[ai][m] = nolw ? 0.5f : ((const float*)slotw)[2 * EPI_ROW(ai, m) + which];
#pragma unroll
        for (int ai = 0; ai < 2; ++ai)
#pragma unroll
            for (int m = 0; m < 4; ++m) { const int slot = EPI_ROW(ai, m); const float w = wv[ai][m]; f32x4 o[2];
#pragma unroll
                for (int n = 0; n < 2; ++n)
#pragma unroll
                    for (int j = 0; j < 4; ++j) { const float a = acc[ai][0][m][n][j]; o[n][j] = w * a * fast_sigmoid(a) * acc[ai][1][m][n][j]; }
                st16(ACT + (size_t)slot * D + ch, pack8(o[0], o[1])); }
    }
};
struct EpiMoeDown { bf16_t* X16; const int* perm; const bf16_t* gate16;
    __device__ __forceinline__ void operator()(EPI_ARGS) const {
        int tok[2][4];
#pragma unroll
        for (int ai = 0; ai < 2; ++ai)
#pragma unroll
            for (int m = 0; m < 4; ++m) tok[ai][m] = perm[EPI_ROW(ai, m)];
#pragma unroll
        for (int ai = 0; ai < 2; ++ai)
#pragma unroll
            for (int m = 0; m < 4; ++m) tok[ai][m] = tok[ai][m] < 0 ? T_ALL : tok[ai][m];
#pragma unroll
        for (int bj = 0; bj < 2; ++bj) { const int col = u.pn * BM + bj * HALF + wc * 32 + fq * 8;
#pragma unroll
            for (int ai = 0; ai < 2; ++ai) { u32x4 xs[4], gs[4];
#pragma unroll
                for (int m = 0; m < 4; ++m) { xs[m] = *(const u32x4*)(X16 + (size_t)tok[ai][m] * D + col); gs[m] = *(const u32x4*)(gate16 + (size_t)modrow_of(tok[ai][m]) * D + col); }
#pragma unroll
                for (int m = 0; m < 4; ++m) { f32x4 x0, x1, g0, g1; unpack8(xs[m], x0, x1); unpack8(gs[m], g0, g1);
                    st16o(X16, (unsigned)(tok[ai][m] * D + col) * 2u, pack8(x0 + g0 * acc[ai][bj][m][0], x1 + g1 * acc[ai][bj][m][1])); } } }
    }
};
struct EpiS5State { float* S;
    __device__ __forceinline__ void operator()(EPI_ARGS) const {
#pragma unroll
        for (int bj = 0; bj < 2; ++bj) { const int col = bj * HALF + wc * 32 + fq * 8;
#pragma unroll
            for (int ai = 0; ai < 2; ++ai)
#pragma unroll
                for (int m = 0; m < 4; ++m) { float* o = S + ((size_t)u.pb * NCHUNK + EPI_ROW(ai, m)) * 256 + col;
                    st16f(o, acc[ai][bj][m][0]); st16f(o + 4, acc[ai][bj][m][1]); } }
    }
};
struct EpiS5Out { bf16_t* YG; const bf16_t* AG; const float* dvec;
    __device__ __forceinline__ void operator()(EPI_ARGS) const {
#pragma unroll
        for (int bj = 0; bj < 2; ++bj) { const int n = u.pn * BM + bj * HALF + wc * 32 + fq * 8, t = n >> 4, ch = u.pb * 16 + (n & 15);
            const f32x4 d0 = *(const f32x4*)(dvec + ch), d1 = *(const f32x4*)(dvec + ch + 4);
            u32x4 us[2][4];
#pragma unroll
            for (int ai = 0; ai < 2; ++ai)
#pragma unroll
                for (int m = 0; m < 4; ++m) us[ai][m] = *(const u32x4*)(AG + ((size_t)u.pb * NCHUNK + EPI_ROW(ai, m)) * AGLD + n);
#pragma unroll
            for (int ai = 0; ai < 2; ++ai)
#pragma unroll
                for (int m = 0; m < 4; ++m) { const int crow = EPI_ROW(ai, m); const u32x4 uu = us[ai][m];
                    f32x4 y0 = acc[ai][bj][m][0], y1 = acc[ai][bj][m][1];
                    y0[0] += d0[0] * bf_lo(uu.x); y0[1] += d0[1] * bf_hi(uu.x); y0[2] += d0[2] * bf_lo(uu.y); y0[3] += d0[3] * bf_hi(uu.y);
                    y1[0] += d1[0] * bf_lo(uu.z); y1[1] += d1[1] * bf_hi(uu.z); y1[2] += d1[2] * bf_lo(uu.w); y1[3] += d1[3] * bf_hi(uu.w);
#pragma unroll
                    for (int j = 0; j < 4; ++j) { const float a = y0[j], b = y1[j];
                        y0[j] = a * fast_sigmoid(1.5957691216f * (a + 0.044715f * a * a * a)); y1[j] = b * fast_sigmoid(1.5957691216f * (b + 0.044715f * b * b * b)); }
                    st16(YG + ((size_t)crow * 32 + t) * D + ch, pack8(y0, y1)); } }
    }
};
}

struct Params { const float* in[33]; float* out; unsigned char* ws; int ph_lo, ph_hi; };
enum { I_X = 0, I_C, I_CTX, I_CCTX, I_ADAW, I_ADAB, I_N1G, I_N2G, I_CWIN, I_CDW, I_CDWB, I_CLNG, I_CLNB, I_CWOUT, I_SWIN, I_SCONV, I_SWOUT,
       I_S5ARE, I_S5AIM, I_S5DT, I_S5BRE, I_S5BIM, I_S5CRE, I_S5CIM, I_S5D, I_S5WGLU, I_WG, I_BG, I_WE, I_BE, I_W13, I_W2, I_FG };

struct ConvJob { const float* src; bf16_t* dst; int K, N, mode, ntile_k, ntile_n, nmat; size_t sstride, dstride; };
__device__ __forceinline__ int conv_dst_row(int mode, int N, int n0) {
    if (mode == 0) return n0;
    if (mode == 1) { const int C = N >> 1, isg = n0 >= C, c = n0 - isg * C; return (c >> 7) * 256 + isg * 128; }
    if (n0 < 1024) return 2048 + n0;
    const int isg = n0 >= 2048, c = n0 - 1024 - isg * 1024; return (c >> 7) * 256 + isg * 128;
}
__device__ void convert_tile(const Frame& F, const ConvJob& J, int t) {
    const int per = J.ntile_k * J.ntile_n, mat = t / per, r = t % per, tk = r / J.ntile_n, tn = r % J.ntile_n;
    const float* src = J.src + (size_t)mat * J.sstride + (size_t)(tk * 64) * J.N + tn * 128;
    LAS unsigned* T = (LAS unsigned*)F.lds;
    __syncthreads();
#pragma unroll
    for (int i = 0; i < 2; ++i) { const int task = F.tid + i * 512, nq = task & 31, kp = task >> 5;
        const f32x4 r0 = *(const f32x4*)(src + (size_t)(2 * kp) * J.N + nq * 4), r1 = *(const f32x4*)(src + (size_t)(2 * kp + 1) * J.N + nq * 4);
#pragma unroll
        for (int j = 0; j < 4; ++j) T[(nq * 4 + j) * 33 + kp] = cvt_pk_bf16(r0[j], r1[j]); }
    __syncthreads();
    bf16_t* dst = J.dst + (size_t)mat * J.dstride + (size_t)conv_dst_row(J.mode, J.N, tn * 128) * J.K + tk * 64;
#pragma unroll
    for (int i = 0; i < 2; ++i) { const int task = F.tid + i * 512, q = task & 7, n = task >> 3;
        u32x4 v; v.x = T[n * 33 + q * 4]; v.y = T[n * 33 + q * 4 + 1]; v.z = T[n * 33 + q * 4 + 2]; v.w = T[n * 33 + q * 4 + 3];
        st16(dst + (size_t)n * J.K + q * 8, v); }
}
__device__ __forceinline__ ConvJob make_job(const Params& p, int j) {
    ConvJob J; unsigned char* ws = p.ws;
    switch (j) {
    case 0: J = ConvJob{p.in[I_CWIN], (bf16_t*)(ws + WS_WCIN), 1024, 2048, 1, 16, 16, 2, (size_t)1024 * 2048, (size_t)2048 * 1024}; break;
    case 1: J = ConvJob{p.in[I_CWOUT], (bf16_t*)(ws + WS_WCOUT), 1024, 1024, 0, 16, 8, 2, (size_t)1024 * 1024, (size_t)1024 * 1024}; break;
    case 2: J = ConvJob{p.in[I_SWIN], (bf16_t*)(ws + WS_WSIN), 1024, 3072, 2, 16, 24, 1, 0, 0}; break;
    case 3: J = ConvJob{p.in[I_SWOUT], (bf16_t*)(ws + WS_WSOUT), 1024, 1024, 0, 16, 8, 1, 0, 0}; break;
    case 4: J = ConvJob{p.in[I_S5WGLU], (bf16_t*)(ws + WS_WGLU), 1024, 2048, 1, 16, 16, 1, 0, 0}; break;
    case 5: J = ConvJob{p.in[I_W13], (bf16_t*)(ws + WS_W13), 1024, 1024, 1, 16, 8, 128, (size_t)1024 * 1024, (size_t)1024 * 1024}; break;
    default: J = ConvJob{p.in[I_W2], (bf16_t*)(ws + WS_W2), 512, 1024, 0, 8, 8, 128, (size_t)512 * 1024, (size_t)1024 * 512}; break;
    }
    return J;
}
__device__ void mod_task(const Frame& F, const Params& p, int t) {
    const int layer = t / 96, n0 = (t % 96) * 64;
    const float* W = p.in[I_ADAW] + (size_t)layer * D * MODW; const float* bias = p.in[I_ADAB] + (size_t)layer * MODW;
    float* mod = (float*)(p.ws + WS_MOD) + (size_t)layer * NMOD * MODW;
    LAS float* sc = (LAS float*)F.lds;
    LAS float* red = (LAS float*)(F.lds + 33 * 512 * 4);
    float acc[NMOD];
#pragma unroll
    for (int r = 0; r < NMOD; ++r) acc[r] = 0.f;
    for (int half = 0; half < 2; ++half) {
        __syncthreads();
        for (int i = F.tid; i < NMOD * 512; i += NTHR) { const int r = i >> 9, k = (i & 511) + half * 512;
            const float v = (r < NB) ? p.in[I_C][r * D + k] : p.in[I_CCTX][k]; sc[i] = v * fast_sigmoid(v); }
        __syncthreads();
#pragma unroll 8
        for (int kk = 0; kk < 64; ++kk) { const int kl = F.wave * 64 + kk; const float w = W[(size_t)(half * 512 + kl) * MODW + n0 + F.lane];
#pragma unroll
            for (int r = 0; r < NMOD; ++r) acc[r] += sc[r * 512 + kl] * w; }
    }
#pragma unroll
    for (int r = 0; r < NMOD; ++r) red[(F.wave * NMOD + r) * 64 + F.lane] = acc[r];
    __syncthreads();
    for (int i = F.tid; i < NMOD * 64; i += NTHR) { const int r = i >> 6, l = i & 63; float s = bias[n0 + l];
#pragma unroll
        for (int w = 0; w < 8; ++w) s += red[(w * NMOD + r) * 64 + l];
        mod[(size_t)r * MODW + n0 + l] = s;
        const int chunk = n0 >> 10;
        if (chunk == 2 || chunk == 5) ((bf16_t*)(p.ws + WS_MODG))[((size_t)(layer * 2 + (chunk == 5)) * NMOD + r) * D + (n0 & 1023) + l] = (bf16_t)(cvt_pk_bf16(s, 0.f) & 0xffffu); }
    __syncthreads();
}
__device__ void s5_build(const Frame& F, const Params& p, int g) {
    LAS f32x2* P = (LAS f32x2*)F.lds;
    LAS f32x2* Bb = (LAS f32x2*)(F.lds + 33792);
    LAS f32x2* Cc = (LAS f32x2*)(F.lds + 33792 + 16384);
    LAS float* Kd = (LAS float*)(F.lds + 33792 + 32768);
    __syncthreads();
    if (F.tid < 128) { const int dir = F.tid >> 6, pp = F.tid & 63, gi = (dir * 64 + g) * 64 + pp;
        double are = (double)p.in[I_S5ARE][gi]; if (are > -1e-4) are = -1e-4; const double aim = (double)p.in[I_S5AIM][gi];
        const double dt = exp((double)p.in[I_S5DT][dir * 64 + g]);
        double ab_re = 0, ab_im = 0;
        for (int n = 0; n <= 32; ++n) { const double mag = exp(n * dt * are), ang = n * dt * aim, cr = mag * cos(ang), ci = mag * sin(ang);
            P[(dir * 64 + pp) * 33 + n] = (f32x2){(float)cr, (float)ci}; if (n == 1) { ab_re = cr; ab_im = ci; }
            if (n == 32) ((f32x2*)(p.ws + WS_A32))[(g * 2 + dir) * 64 + pp] = (f32x2){(float)cr, (float)ci}; }
        const double den = are * are + aim * aim, nre = ab_re - 1.0, nim = ab_im;
        const double kre = (nre * are + nim * aim) / den, kim = (nim * are - nre * aim) / den;
        for (int c = 0; c < 16; ++c) { const double br = (double)p.in[I_S5BRE][(size_t)gi * 16 + c], bi = (double)p.in[I_S5BIM][(size_t)gi * 16 + c];
            Bb[(dir * 64 + pp) * 16 + c] = (f32x2){(float)(kre * br - kim * bi), (float)(kre * bi + kim * br)}; }
        for (int c = 0; c < 16; ++c) { const size_t ci = ((size_t)(dir * 64 + g) * 16 + c) * 64 + pp;
            Cc[(dir * 16 + c) * 64 + pp] = (f32x2){p.in[I_S5CRE][ci], p.in[I_S5CIM][ci]}; }
    }
    __syncthreads();
    for (int e = F.tid; e < 2 * 32 * 256; e += NTHR) { const int dir = e >> 13, d = (e >> 8) & 31, c = (e >> 4) & 15, c2 = e & 15; float s = 0.f;
#pragma unroll 2
        for (int pp = 0; pp < 64; ++pp) { const f32x2 C = Cc[(dir * 16 + c) * 64 + pp], E = P[(dir * 64 + pp) * 33 + d], B = Bb[(dir * 64 + pp) * 16 + c2];
            const float er = E.x * B.x - E.y * B.y, ei = E.x * B.y + E.y * B.x; s += C.x * er - C.y * ei; }
        Kd[e] = s; }
    __syncthreads();
    unsigned* WT = (unsigned*)(p.ws + WS_S5WT) + (size_t)g * 512 * 384;
    for (int e = F.tid; e < 512 * 384; e += NTHR) { const int n = e / 384, k0 = (e % 384) * 2, t = n >> 4, c = n & 15; float v[2];
#pragma unroll
        for (int h = 0; h < 2; ++h) { const int k = k0 + h;
            if (k < 512) { const int s = k >> 4, c2 = k & 15;
                v[h] = (s < t) ? Kd[((0 * 32 + (t - s)) * 16 + c) * 16 + c2] : (s > t) ? Kd[((1 * 32 + (s - t)) * 16 + c) * 16 + c2] : (Kd[(c) * 16 + c2] + Kd[((32) * 16 + c) * 16 + c2]);
            } else { const int kk = k - 512, dir = kk >> 7, pp = (kk >> 1) & 63, ri = kk & 1;
                const f32x2 E = P[(dir * 64 + pp) * 33 + (dir == 0 ? t + 1 : 32 - t)], C = Cc[(dir * 16 + c) * 64 + pp];
                const float cr = C.x * E.x - C.y * E.y, ci = C.x * E.y + C.y * E.x; v[h] = ri ? -ci : cr; } }
        WT[e] = cvt_pk_bf16(v[0], v[1]); }
    unsigned* WSm = (unsigned*)(p.ws + WS_S5WS) + (size_t)g * 256 * 256;
    for (int e = F.tid; e < 256 * 256; e += NTHR) { const int n = e >> 8, k0 = (e & 255) * 2, dir = n >> 7, pp = (n >> 1) & 63, ri = n & 1; float v[2];
#pragma unroll
        for (int h = 0; h < 2; ++h) { const int k = k0 + h, s = k >> 4, c = k & 15;
            const f32x2 E = P[(dir * 64 + pp) * 33 + (dir == 0 ? 31 - s : s)], B = Bb[(dir * 64 + pp) * 16 + c];
            v[h] = ri ? (E.x * B.y + E.y * B.x) : (E.x * B.x - E.y * B.y); }
        WSm[e] = cvt_pk_bf16(v[0], v[1]); }
    __syncthreads();
}
__device__ __forceinline__ void prologue_phase(const Frame& F0, const Params& p) {
    const Frame F = phase_frame(F0.lds);
    if (F.bid < 64) s5_build(F, p, F.bid);
    else for (int t = F.bid - 64; t < 4 * 96; t += F.G - 64) mod_task(F, p, t);
    unsigned* qhead = (unsigned*)(p.ws + WS_CTL + CTL_QUEUE);
    LAS int* bc = (LAS int*)(F.lds + LDS_MISC);
    int jbase[8]; jbase[0] = 0;
#pragma unroll
    for (int j = 0; j < 7; ++j) { const ConvJob J = make_job(p, j); jbase[j + 1] = jbase[j] + J.ntile_k * J.ntile_n * J.nmat; }
    for (;;) {
        __syncthreads();
        if (F.tid == 0) bc[0] = (int)__hip_atomic_fetch_add(qhead, 1u, __ATOMIC_RELAXED, __HIP_MEMORY_SCOPE_AGENT);
        __syncthreads();
        const int t0 = bc[0] * 4;
        if (t0 >= jbase[7]) break;
        int j = 0;
#pragma unroll
        for (int k = 1; k < 7; ++k) if (t0 >= jbase[k]) j = k;
        const ConvJob J = make_job(p, j);
        int jb = 0;
#pragma unroll
        for (int k = 0; k < 7; ++k) if (k == j) jb = jbase[k];
        for (int t = t0; t < t0 + 4; ++t) convert_tile(F, J, t - jb);
    }
    __syncthreads();
}

template <int MODE, bool F32SRC>
__device__ __forceinline__ void norm_phase(const Frame& F0, const Params& p, const float* src_lat, const float* src_ctx_adj, const bf16_t* X16, int nrows, const float* gvec, const float* msc, const float* msh,
                           int layer, float* outf) {
    const Frame F = phase_frame(F0.lds);
    bf16_t* H = (bf16_t*)(p.ws + WS_H); bf16_t* AG = (bf16_t*)(p.ws + WS_T1);
    LAS f32x4* Wl = (LAS f32x4*)F.lds;
    LAS int* lcnt = (LAS int*)(F.lds + LDS_MISC);
    LAS float* lbias = (LAS float*)(F.lds + LDS_MISC + 512);
    if (MODE == 2) {
        __syncthreads();
        const float* wg = p.in[I_WG] + (size_t)layer * D * 4; const float* we = p.in[I_WE] + (size_t)layer * D * 32;
        LAS float* Wf = (LAS float*)F.lds;
        for (int i = F.tid; i < D * 4; i += NTHR) { const int c = i >> 2, j = i & 3, q4 = (c >> 9) * 2 + ((c >> 2) & 1), ln = (c & 511) >> 3; Wf[((j * 4 + q4) * 64 + ln) * 4 + (c & 3)] = wg[i]; }
        for (int i = F.tid; i < D * 32; i += NTHR) { const int c = i >> 5, j = 4 + (i & 31), q4 = (c >> 9) * 2 + ((c >> 2) & 1), ln = (c & 511) >> 3; Wf[((j * 4 + q4) * 64 + ln) * 4 + (c & 3)] = we[i]; }
        for (int i = F.tid; i < NBUCKET; i += NTHR) lcnt[i] = 0;
        if (F.tid < 4) lbias[F.tid] = p.in[I_BG][layer * 4 + F.tid];
        if (F.tid >= 64 && F.tid < 96) lbias[4 + F.tid - 64] = p.in[I_BE][layer * 32 + F.tid - 64];
        __syncthreads();
    }
    const int rpb = nrows / F.G, r0 = F.bid * rpb;
    f32x4 gm[4], sh[4]; int cur_mr = -1;
    if (MODE == 3) {
#pragma unroll
        for (int q4 = 0; q4 < 4; ++q4) gm[q4] = *(const f32x4*)(gvec + 8 * F.lane + 512 * (q4 >> 1) + 4 * (q4 & 1));
    }
    f32x4 xf[2][4], nf[2][4]; u32x4 xr[2][2], nr[2][2];
#define NORM_LOAD(dstf, dstr, rbase) do { _Pragma("unroll") for (int j = 0; j < 2; ++j) { const int row = r0 + (rbase) + j; \
        if (F32SRC) { const float* xp = (row < T_LAT ? src_lat : src_ctx_adj) + (size_t)row * D; \
            _Pragma("unroll") for (int q4 = 0; q4 < 4; ++q4) dstf[j][q4] = *(const f32x4*)(xp + 8 * F.lane + 512 * (q4 >> 1) + 4 * (q4 & 1)); \
        } else { _Pragma("unroll") for (int q = 0; q < 2; ++q) dstr[j][q] = *(const u32x4*)(X16 + (size_t)row * D + 8 * F.lane + 512 * q); } } } while (0)
    NORM_LOAD(nf, nr, F.wave * 2);
    for (int rr = F.wave * 2; rr < rpb; rr += 16) {
#pragma unroll
        for (int j = 0; j < 2; ++j) {
            if (F32SRC) {
#pragma unroll
                for (int q4 = 0; q4 < 4; ++q4) xf[j][q4] = nf[j][q4];
            } else { xr[j][0] = nr[j][0]; xr[j][1] = nr[j][1]; } }
        if (rr + 16 < rpb) NORM_LOAD(nf, nr, rr + 16);
#pragma unroll
        for (int j = 0; j < 2; ++j) { const int row = r0 + rr + j;
            f32x4 xv[4];
            if (F32SRC) {
#pragma unroll
                for (int q4 = 0; q4 < 4; ++q4) xv[q4] = xf[j][q4];
            } else { pg8::unpack8(xr[j][0], xv[0], xv[1]); pg8::unpack8(xr[j][1], xv[2], xv[3]); }
            float ss = 0.f;
#pragma unroll
            for (int q4 = 0; q4 < 4; ++q4) ss += xv[q4][0] * xv[q4][0] + xv[q4][1] * xv[q4][1] + xv[q4][2] * xv[q4][2] + xv[q4][3] * xv[q4][3];
            ss = wave_allsum(ss);
            const float rstd = rsqrtf(ss * (1.0f / D) + 1e-6f);
            if (MODE == 3) {
#pragma unroll
                for (int q4 = 0; q4 < 4; ++q4) st16f(outf + (size_t)row * D + 8 * F.lane + 512 * (q4 >> 1) + 4 * (q4 & 1), xv[q4] * rstd * gm[q4]);
                continue;
            }
            const int mr = modrow_of(row);
            if (mr != cur_mr) { cur_mr = mr;
#pragma unroll
                for (int q4 = 0; q4 < 4; ++q4) { const int c = 8 * F.lane + 512 * (q4 >> 1) + 4 * (q4 & 1);
                    const f32x4 gq = *(const f32x4*)(gvec + c), sc = *(const f32x4*)(msc + (size_t)mr * MODW + c);
                    gm[q4] = gq * (1.0f + sc); sh[q4] = *(const f32x4*)(msh + (size_t)mr * MODW + c); } }
            f32x4 hv[4];
#pragma unroll
            for (int q4 = 0; q4 < 4; ++q4) hv[q4] = xv[q4] * rstd * gm[q4] + sh[q4];
            if (MODE == 1) { const int chunk = row >> 5, t = row & 31;
#pragma unroll
                for (int q = 0; q < 2; ++q) { const int gi = (F.lane >> 1) + 32 * q, c = 8 * (F.lane & 1);
                    st16(AG + ((size_t)gi * NCHUNK + chunk) * AGLD + t * 16 + c, pg8::pack8(hv[2 * q], hv[2 * q + 1])); }
            } else {
#pragma unroll
                for (int q = 0; q < 2; ++q) st16(H + (size_t)row * D + 8 * F.lane + 512 * q, pg8::pack8(hv[2 * q], hv[2 * q + 1]));
            }
            if (MODE == 2) {
                float lg[4];
#pragma unroll
                for (int jg = 0; jg < 4; ++jg) { float sacc = 0.f;
#pragma unroll
                    for (int q4 = 0; q4 < 4; ++q4) { const f32x4 w = Wl[(jg * 4 + q4) * 64 + F.lane]; sacc += hv[q4][0] * w[0] + hv[q4][1] * w[1] + hv[q4][2] * w[2] + hv[q4][3] * w[3]; }
                    lg[jg] = sacc; }
                wave_sum4(lg, F.lane);
#pragma unroll
                for (int jg = 0; jg < 4; ++jg) lg[jg] += lbias[jg];
                int gsel = 0; float gmax = lg[0];
#pragma unroll
                for (int jg = 1; jg < 4; ++jg) if (lg[jg] > gmax) { gmax = lg[jg]; gsel = jg; }
                float gden = 0.f;
#pragma unroll
                for (int jg = 0; jg < 4; ++jg) gden += __expf(lg[jg] - gmax);
                const float gw = 1.0f / gden;
                gsel = __builtin_amdgcn_readfirstlane(gsel);
                float le[8];
#pragma unroll
                for (int e = 0; e < 8; ++e) { float sacc = 0.f; const int jr = 4 + gsel * 8 + e;
#pragma unroll
                    for (int q4 = 0; q4 < 4; ++q4) { const f32x4 w = Wl[(jr * 4 + q4) * 64 + F.lane]; sacc += hv[q4][0] * w[0] + hv[q4][1] * w[1] + hv[q4][2] * w[2] + hv[q4][3] * w[3]; }
                    le[e] = sacc; }
                wave_sum8(le, F.lane);
#pragma unroll
                for (int e = 0; e < 8; ++e) le[e] += lbias[4 + gsel * 8 + e];
                int i1 = 0; float l1 = le[0];
#pragma unroll
                for (int e = 1; e < 8; ++e) if (le[e] > l1) { l1 = le[e]; i1 = e; }
                int i2 = -1; float l2 = -3.0e38f;
#pragma unroll
                for (int e = 0; e < 8; ++e) if (e != i1 && le[e] > l2) { l2 = le[e]; i2 = e; }
                if (i2 < 0) i2 = (i1 == 0) ? 1 : 0;
                const float r = __expf(l2 - l1), w1 = gw / (1.0f + r), w2 = gw * r / (1.0f + r);
                const int lo = i1 < i2 ? i1 : i2, hi = i1 < i2 ? i2 : i1; const float wlo = i1 < i2 ? w1 : w2, whi = i1 < i2 ? w2 : w1;
                const int bucket = gsel * 28 + lo * 8 - (lo * (lo + 1)) / 2 + (hi - lo - 1);
                if (F.lane == 0) { const int rank = __hip_atomic_fetch_add(lcnt + bucket, 1, __ATOMIC_RELAXED, __HIP_MEMORY_SCOPE_WORKGROUP);
                    i32x4 info; info.x = bucket; info.y = rank; info.z = __float_as_int(wlo); info.w = __float_as_int(whi);
                    *(i32x4*)(p.ws + WS_TOK + (size_t)row * 16) = info; }
            }
        }
    }
#undef NORM_LOAD
    if (MODE == 2) { __syncthreads();
        for (int i = F.tid; i < NBUCKET; i += NTHR) ((int*)(p.ws + WS_CNT))[F.bid * NBUCKET + i] = lcnt[i];
        __syncthreads(); }
}

__device__ __forceinline__ void dispatch_phase(const Frame& F0, const Params& p, int nrows) {
    const Frame F = phase_frame(F0.lds);
    LAS int* tot = (LAS int*)(F.lds);
    LAS int* pre = (LAS int*)(F.lds + 512);
    LAS int* base = (LAS int*)(F.lds + 1024);
    const int* cnt = (const int*)(p.ws + WS_CNT);
    __syncthreads();
    if (F.tid < NBUCKET) { int s = 0, pr = 0;
        for (int b = 0; b < F.G; ++b) { const int v = cnt[b * NBUCKET + F.tid]; pr = (b == F.bid) ? s : pr; s += v; }
        tot[F.tid] = s; pre[F.tid] = pr; }
    __syncthreads();
    if (F.tid == 0) { int o = 0; for (int k = 0; k < NBUCKET; ++k) { base[k] = o; o += (tot[k] + 255) & ~255; } base[NBUCKET] = o; }
    __syncthreads();
    int* perm = (int*)(p.ws + WS_PERM); f32x2* slotw = (f32x2*)(p.ws + WS_SLOTW); int* tile = (int*)(p.ws + WS_TILE);
    if (F.bid == 0) {
        if (F.tid == 0) tile[0] = base[NBUCKET] >> 8;
        for (int k = F.tid; k < NBUCKET; k += NTHR) { const int g = k / 28, pid = k % 28; int lo = 0, rem = pid; while (rem >= 7 - lo) { rem -= 7 - lo; ++lo; } const int hi = lo + 1 + rem;
            const int ee = (g * 8 + lo) | ((g * 8 + hi) << 8);
            for (int mt = base[k] >> 8; mt < (base[k + 1] >> 8); ++mt) tile[16 + mt] = ee; }
    }
    for (int k = F.bid; k < NBUCKET; k += F.G)
        for (int s = base[k] + tot[k] + F.tid; s < base[k + 1]; s += NTHR) { perm[s] = -1; slotw[s] = (f32x2){0.f, 0.f}; }
    const int rpb = nrows / F.G, r0 = F.bid * rpb;
    for (int rr = F.tid; rr < rpb; rr += NTHR) { const int row = r0 + rr;
        const i32x4 info = *(const i32x4*)(p.ws + WS_TOK + (size_t)row * 16);
        const int pos = base[info.x] + pre[info.x] + info.y;
        perm[pos] = row; slotw[pos] = (f32x2){__int_as_float(info.z), __int_as_float(info.w)}; }
    __syncthreads();
}

__device__ __forceinline__ const LAS int* moe_tile_table(const Frame& F0, const Params& p) {
    const Frame F = phase_frame(F0.lds);
    LAS int* lt = (LAS int*)(F.lds + LDS_MISC);
    const int* tile = (const int*)(p.ws + WS_TILE);
    __syncthreads();
    for (int i = F.tid; i < 16 + SLOTS_MAX / 256; i += NTHR) lt[i] = tile[i];
    __syncthreads();
    return lt;
}

template <bool CTX>
__device__ __forceinline__ void conv31_unit(const Frame& F, const bf16_t* Z, bf16_t* A2, int unit, int next_unit, unsigned (&rin)[32], const f32x2 (&w)[31], f32x2 bias, f32x2 lg, f32x2 lb) {
    constexpr int NIN = CTX ? 62 : 32;
    f32x2 xin[NIN]; int tok0, tstride;
    if (CTX) { const int b = unit >> 3, p0 = (unit & 7) * 32; tok0 = T_LAT + b * LCTX + p0; tstride = 1;
#pragma unroll
        for (int j = 0; j < NIN; ++j) { const int pos = p0 - 15 + j; const unsigned v = (pos >= 0 && pos < LCTX) ? *(const unsigned*)(Z + (size_t)(tok0 - 15 + j) * D + 2 * F.tid) : 0u; xin[j] = (f32x2){bf_lo(v), bf_hi(v)}; }
    } else { const int b = unit >> 6, col = unit & 63; tok0 = b * SEQ + col; tstride = 64;
#pragma unroll
        for (int j = 0; j < 32; ++j) xin[j] = (f32x2){bf_lo(rin[j]), bf_hi(rin[j])};
        if (next_unit >= 0) { const int nb = next_unit >> 6, ncol = next_unit & 63, ntok = nb * SEQ + ncol;
#pragma unroll
            for (int j = 0; j < 32; ++j) rin[j] = *(const unsigned*)(Z + (size_t)(ntok + j * 64) * D + 2 * F.tid); }
    }
    f32x2 o[32];
#pragma unroll
    for (int r = 0; r < 32; ++r) { f32x2 s = bias;
#pragma unroll
        for (int k = 0; k < 31; ++k) { const int j = CTX ? r + k : r + k - 15;
            if (j >= 0 && j < NIN) s += w[k] * xin[j]; }
        o[r] = s; }
    float v[64];
#pragma unroll
    for (int r = 0; r < 32; ++r) { v[r] = o[r].x + o[r].y; v[32 + r] = o[r].x * o[r].x + o[r].y * o[r].y; }
#pragma unroll
    for (int st = 32; st >= 1; st >>= 1) { const bool up = (F.lane & st) != 0;
#pragma unroll
        for (int i = 0; i < st; ++i) { const float mine = up ? v[st + i] : v[i], other = up ? v[i] : v[st + i]; v[i] = mine + __shfl_xor(other, st); } }
    LAS float* red = (LAS float*)F.lds;
    LAS float* stat = (LAS float*)(F.lds + 2048);
    __syncthreads();
    red[F.wave * 64 + F.lane] = v[0];
    __syncthreads();
    if (F.tid < 64) { float s = 0.f;
#pragma unroll
        for (int wv = 0; wv < 8; ++wv) s += red[wv * 64 + F.tid];
        stat[F.tid] = s * (1.0f / D); }
    __syncthreads();
#pragma unroll
    for (int r = 0; r < 32; ++r) { const float mu = stat[r], var = stat[32 + r] - mu * mu, rstd = rsqrtf(var + 1e-5f);
        const float y0 = (o[r].x - mu) * rstd * lg.x + lb.x, y1 = (o[r].y - mu) * rstd * lg.y + lb.y;
        *(unsigned*)(A2 + (size_t)(tok0 + r * tstride) * D + 2 * F.tid) = cvt_pk_bf16(y0 * fast_sigmoid(y0), y1 * fast_sigmoid(y1)); }
}
__device__ __forceinline__ void conv31_phase(const Frame& F0, const Params& p, int j, bool with_ctx) {
    const Frame F = phase_frame(F0.lds);
    const bf16_t* Z = (const bf16_t*)(p.ws + WS_T1); bf16_t* A2 = (bf16_t*)(p.ws + WS_T3);
    f32x2 w[31];
#pragma unroll
    for (int k = 0; k < 31; ++k) w[k] = *(const f32x2*)(p.in[I_CDW] + ((size_t)j * 31 + k) * D + 2 * F.tid);
    const f32x2 bias = *(const f32x2*)(p.in[I_CDWB] + (size_t)j * D + 2 * F.tid), lg = *(const f32x2*)(p.in[I_CLNG] + (size_t)j * D + 2 * F.tid), lb = *(const f32x2*)(p.in[I_CLNB] + (size_t)j * D + 2 * F.tid);
    const int nlat = NB * 64, ntot = nlat + (with_ctx ? NB * 8 : 0);
    unsigned rin[32];
    { const int u0 = F.bid, b = u0 >> 6, col = u0 & 63, tok = b * SEQ + col;
#pragma unroll
      for (int jj = 0; jj < 32; ++jj) rin[jj] = *(const unsigned*)(Z + (size_t)(tok + jj * 64) * D + 2 * F.tid); }
    for (int u = F.bid; u < ntot; u += F.G) {
        const int un = u + F.G;
        if (u < nlat) conv31_unit<false>(F, Z, A2, u, un < nlat ? un : -1, rin, w, bias, lg, lb);
        else conv31_unit<true>(F, Z, A2, u - nlat, -1, rin, w, bias, lg, lb);
    }
    __syncthreads();
}

__device__ __forceinline__ void scpre_phase(const Frame& F0, const Params& p) {
    const Frame F = phase_frame(F0.lds);
    const bf16_t* P = (const bf16_t*)(p.ws + WS_T1); const bf16_t* GB = (const bf16_t*)(p.ws + WS_T2); bf16_t* A2 = (bf16_t*)(p.ws + WS_T3);
    const float* cw = p.in[I_SCONV];
    for (int e = F.bid * NTHR + F.tid; e < T_ALL * 128; e += F.G * NTHR) { const int row = e >> 7, ch = (e & 127) * 8;
        bool lv, rv; if (row < T_LAT) { lv = (row & 63) != 0; rv = (row & 63) != 63; } else { const int l = (row - T_LAT) & 255; lv = l != 0; rv = l != 255; }
        const u32x4 z = (u32x4){0u, 0u, 0u, 0u};
        const u32x4 pc = *(const u32x4*)(P + (size_t)row * D + ch), pl = lv ? *(const u32x4*)(P + (size_t)(row - 1) * D + ch) : z, pr = rv ? *(const u32x4*)(P + (size_t)(row + 1) * D + ch) : z;
        const u32x4 gb = *(const u32x4*)(GB + (size_t)row * D + ch);
        float o[8];
#pragma unroll
        for (int q = 0; q < 4; ++q) { const f32x2 w0 = *(const f32x2*)(cw + ch + 2 * q), w1 = *(const f32x2*)(cw + D + ch + 2 * q), w2 = *(const f32x2*)(cw + 2 * D + ch + 2 * q);
            o[2 * q] = bf_lo(gb[q]) * (w0.x * bf_lo(pl[q]) + w1.x * bf_lo(pc[q]) + w2.x * bf_lo(pr[q]));
            o[2 * q + 1] = bf_hi(gb[q]) * (w0.y * bf_hi(pl[q]) + w1.y * bf_hi(pc[q]) + w2.y * bf_hi(pr[q])); }
        u32x4 w; w.x = cvt_pk_bf16(o[0], o[1]); w.y = cvt_pk_bf16(o[2], o[3]); w.z = cvt_pk_bf16(o[4], o[5]); w.w = cvt_pk_bf16(o[6], o[7]);
        st16(A2 + (size_t)row * D + ch, w); }
}

__device__ __forceinline__ void s5scan_phase(const Frame& F0, const Params& p) {
    const Frame F = phase_frame(F0.lds);
    const float* S = (const float*)(p.ws + WS_T2); bf16_t* AG = (bf16_t*)(p.ws + WS_T1); const f32x2* A32 = (const f32x2*)(p.ws + WS_A32);
    for (int idx = F.bid * NTHR + F.tid; idx < NB * 64 * 2 * 64; idx += F.G * NTHR) {
        const int pp = idx & 63, dir = (idx >> 6) & 1, g = (idx >> 7) & 63, b = idx >> 13;
        const f32x2 a = A32[(g * 2 + dir) * 64 + pp]; float hr = 0.f, hi = 0.f;
        const int col = dir * 128 + 2 * pp;
        for (int st = 0; st < 72; ++st) { int crow;
            if (st < 8) crow = 2048 + b * 8 + (dir ? 7 - st : st); else crow = b * 64 + (dir ? 71 - st : st - 8);
            const size_t ro = (size_t)g * NCHUNK + crow;
            *(unsigned*)(AG + ro * AGLD + 512 + col) = cvt_pk_bf16(hr, hi);
            const f32x2 s = *(const f32x2*)(S + ro * 256 + col);
            const float nr = a.x * hr - a.y * hi + s.x, ni = a.x * hi + a.y * hr + s.y; hr = nr; hi = ni; }
    }
}

__global__ void __launch_bounds__(NTHR, 2) mega(Params p) {
    extern __shared__ __attribute__((aligned(16))) unsigned char lds_raw[];
    Frame F; F.lds = (LAS unsigned char*)lds_raw; F.tid = threadIdx.x; F.lane = F.tid & 63; F.wave = __builtin_amdgcn_readfirstlane(F.tid >> 6); F.G = gridDim.x; F.bid = blockIdx.x;
    unsigned char* ws = p.ws;
#if MK_ONE_LAUNCH
    if (F.tid < 4) ((LAS unsigned*)(F.lds + LDS_BARW))[F.tid] = 0u;
    __syncthreads();
    XcdBarrier bar = xcd_barrier_post((unsigned*)(ws + WS_CTL), (volatile LAS unsigned*)(F.lds + LDS_BARW));
#define GRID_BAR() xcd_barrier(bar)
#else
#define GRID_BAR() do {} while (0)
#endif
    const int lo = p.ph_lo, hi = p.ph_hi;
#ifndef PH_MASK
#define PH_MASK 0xFFFFFFFFu
#endif
#define EN(b) ((PH_MASK >> (b)) & 1u)
#ifndef REP_K2
#define REP_K2 0
#endif
#ifndef REP_MASK
#define REP_MASK 0u
#endif
#define NREP(b) (((REP_MASK >> (b)) & 1u) ? 2 : 1)
#define XSEL(b) ((rep + 1 < NREP(b)) ? X2 : X)
#define IN(k) (lo <= (k) && (k) < hi)
#define SEAM(k) do { if (IN(k) && IN((k) + 1)) GRID_BAR(); } while (0)
    bf16_t* X = (bf16_t*)(ws + WS_X); bf16_t* X2 = (bf16_t*)(ws + WS_END); bf16_t* H = (bf16_t*)(ws + WS_H);
    bf16_t* T1 = (bf16_t*)(ws + WS_T1); bf16_t* T2 = (bf16_t*)(ws + WS_T2); bf16_t* A2 = (bf16_t*)(ws + WS_T3);
    const float* mod = (const float*)(ws + WS_MOD);
    const float* x_in = p.in[I_X]; const float* ctx_adj = p.in[I_CTX] - (size_t)T_LAT * D;

    if (REP_K2 == 3) {
        f32x4 a0 = {0.f, 0.f, 0.f, 0.f}, a1 = a0, a2 = a0, a3 = a0; bf16x8 fa, fb;
#pragma unroll
        for (int i = 0; i < 8; ++i) { fa[i] = (short)(0x3f80 + F.lane); fb[i] = (short)(0x3c00 + F.tid); }
        for (int it = 0; it < 4000; ++it) {
            a0 = __builtin_amdgcn_mfma_f32_16x16x32_bf16(fa, fb, a0, 0, 0, 0); a1 = __builtin_amdgcn_mfma_f32_16x16x32_bf16(fa, fb, a1, 0, 0, 0);
            a2 = __builtin_amdgcn_mfma_f32_16x16x32_bf16(fa, fb, a2, 0, 0, 0); a3 = __builtin_amdgcn_mfma_f32_16x16x32_bf16(fa, fb, a3, 0, 0, 0); }
        if (a0[0] + a1[1] + a2[2] + a3[3] == 123.456f) p.out[F.tid] = a0[0];
    }
    if (EN(0) && IN(0)) for (int rep = 0; rep < NREP(0); ++rep) { prologue_phase(F, p); } SEAM(0);

#pragma unroll
    for (int layer = 0; layer < DEPTH; ++layer) {
        const int pb = 1 + layer * 10, kind = layer % 3, jj = layer / 3;
        const bool upd = layer < DEPTH - 1; const int M = upd ? T_ALL : T_LAT;
        const float* ml = mod + (size_t)layer * NMOD * MODW;
        const bf16_t* mg16 = (const bf16_t*)(ws + WS_MODG) + (size_t)layer * 2 * NMOD * D;
        if (kind == 0) {
            if (EN(1) && IN(pb + 0)) for (int rep = 0; rep < NREP(1); ++rep) { if (layer == 0) norm_phase<0, true>(F, p, x_in, ctx_adj, X, M, p.in[I_N1G] + layer * D, ml + D, ml, layer, nullptr);
                else norm_phase<0, false>(F, p, x_in, ctx_adj, X, M, p.in[I_N1G] + layer * D, ml + D, ml, layer, nullptr); }
            SEAM(pb + 0);
            if (EN(3) && IN(pb + 1)) for (int rep = 0; rep < NREP(3); ++rep) { pg8::DenseOrder S; S.init(H, ws + WS_WCIN + (size_t)jj * 2048 * 1024 * 2, M, 2048, D, D, 1, 0, 0, F.G, F.bid); S.same = (REP_K2 == 2 && rep + 1 < NREP(3)) ? 1 : 0;
                pg8::EpiGlu E{T1}; pg8::gemm_phase(F.lds, pg8::GemmDesc{D, D, (REP_K2 == 1 && rep + 1 < NREP(3)) ? 2 * D : D, 1 << 20}, S, E); }
            SEAM(pb + 1);
            if (EN(4) && IN(pb + 2)) for (int rep = 0; rep < NREP(4); ++rep) conv31_phase(F, p, jj, upd);
            SEAM(pb + 2);
            if (EN(5) && IN(pb + 3)) for (int rep = 0; rep < NREP(5); ++rep) { pg8::DenseOrder S; S.init(A2, ws + WS_WCOUT + (size_t)jj * 1024 * 1024 * 2, M, 1024, D, D, 1, 0, 0, F.G, F.bid);
                if (layer == 0) { pg8::EpiResid<true> E{x_in, ctx_adj, XSEL(5), mg16}; pg8::gemm_phase(F.lds, pg8::GemmDesc{D, D, D, 1 << 20}, S, E); }
                else { pg8::EpiResid<false> E{x_in, ctx_adj, XSEL(5), mg16}; pg8::gemm_phase(F.lds, pg8::GemmDesc{D, D, D, 1 << 20}, S, E); } }
            SEAM(pb + 3);
        } else if (kind == 1) {
            if (EN(1) && IN(pb + 0)) for (int rep = 0; rep < NREP(1); ++rep) norm_phase<0, false>(F, p, x_in, ctx_adj, X, M, p.in[I_N1G] + layer * D, ml + D, ml, layer, nullptr);
            SEAM(pb + 0);
            if (EN(6) && IN(pb + 1)) for (int rep = 0; rep < NREP(6); ++rep) { pg8::DenseOrder S; S.init(H, ws + WS_WSIN, M, 3072, D, D, 1, 0, 0, F.G, F.bid);
                pg8::EpiSc E{T1, T2}; pg8::gemm_phase(F.lds, pg8::GemmDesc{D, D, D, 1 << 20}, S, E); }
            SEAM(pb + 1);
            if (EN(7) && IN(pb + 2)) for (int rep = 0; rep < NREP(7); ++rep) scpre_phase(F, p);
            SEAM(pb + 2);
            if (EN(8) && IN(pb + 3)) for (int rep = 0; rep < NREP(8); ++rep) { pg8::DenseOrder S; S.init(A2, ws + WS_WSOUT, M, 1024, D, D, 1, 0, 0, F.G, F.bid);
                pg8::EpiResid<false> E{x_in, ctx_adj, XSEL(8), mg16}; pg8::gemm_phase(F.lds, pg8::GemmDesc{D, D, D, 1 << 20}, S, E); }
            SEAM(pb + 3);
        } else {
            if (EN(2) && IN(pb + 0)) for (int rep = 0; rep < NREP(2); ++rep) norm_phase<1, false>(F, p, x_in, ctx_adj, X, M, p.in[I_N1G] + layer * D, ml + D, ml, layer, nullptr);
            SEAM(pb + 0);
            if (EN(9) && IN(pb + 1)) for (int rep = 0; rep < NREP(9); ++rep) { pg8::DenseOrder S; S.init(T1, ws + WS_S5WS, NCHUNK, 256, AGLD, 512, 64, (size_t)NCHUNK * AGLD * 2, (size_t)256 * 512 * 2, F.G, F.bid);
                pg8::EpiS5State E{(float*)T2}; pg8::gemm_phase(F.lds, pg8::GemmDesc{AGLD, 512, 512, 1 << 20}, S, E); }
            SEAM(pb + 1);
            if (EN(10) && IN(pb + 2)) for (int rep = 0; rep < NREP(10); ++rep) s5scan_phase(F, p);
            SEAM(pb + 2);
            if (EN(11) && IN(pb + 3)) for (int rep = 0; rep < NREP(11); ++rep) { pg8::DenseOrder S; S.init(T1, ws + WS_S5WT, NCHUNK, 512, AGLD, AGLD, 64, (size_t)NCHUNK * AGLD * 2, (size_t)512 * AGLD * 2, F.G, F.bid);
                pg8::EpiS5Out E{A2, T1, p.in[I_S5D]}; pg8::gemm_phase(F.lds, pg8::GemmDesc{AGLD, AGLD, AGLD, 1 << 20}, S, E); }
            SEAM(pb + 3);
            if (EN(12) && IN(pb + 4)) for (int rep = 0; rep < NREP(12); ++rep) { pg8::DenseOrder S; S.init(A2, ws + WS_WGLU, M, 2048, D, D, 1, 0, 0, F.G, F.bid);
                pg8::EpiGluResid E{XSEL(12), mg16}; pg8::gemm_phase(F.lds, pg8::GemmDesc{D, D, D, 1 << 20}, S, E); }
            SEAM(pb + 4);
        }
        if (EN(13) && IN(pb + 5)) for (int rep = 0; rep < NREP(13); ++rep) norm_phase<2, false>(F, p, x_in, ctx_adj, X, M, p.in[I_N2G] + layer * D, ml + 4 * D, ml + 3 * D, layer, nullptr);
        SEAM(pb + 5);
        if (EN(14) && IN(pb + 6)) for (int rep = 0; rep < NREP(14); ++rep) dispatch_phase(F, p, M);
        SEAM(pb + 6);
        if (EN(15) && IN(pb + 7)) for (int rep = 0; rep < NREP(15); ++rep) { const LAS int* lt = moe_tile_table(F, p); pg8::MoeOrder<1> S; S.init(H, ws + WS_W13 + (size_t)layer * 32 * 1024 * 1024 * 2, lt, (const int*)(ws + WS_PERM), F.G, F.bid);
            if (rep + 1 < NREP(15)) S.dense = (REP_K2 == 7) ? 2 : (REP_K2 == 5 || REP_K2 == 6); pg8::EpiSwiglu E{T2, (const f32x2*)(ws + WS_SLOTW), (rep + 1 < NREP(15) && (REP_K2 == 4 || REP_K2 == 6)) ? 1 : 0}; pg8::gemm_phase(F.lds, pg8::GemmDesc{D, D, D, 1 << 20}, S, E); }
        SEAM(pb + 7);
        if (EN(16) && IN(pb + 8)) for (int rep = 0; rep < NREP(16); ++rep) { const LAS int* lt = moe_tile_table(F, p); pg8::MoeOrder<2> S; S.init(T2, ws + WS_W2 + (size_t)layer * 32 * 1024 * 512 * 2, lt, (const int*)(ws + WS_PERM), F.G, F.bid);
            pg8::EpiMoeDown E{XSEL(16), (const int*)(ws + WS_PERM), mg16 + (size_t)NMOD * D}; pg8::gemm_phase(F.lds, pg8::GemmDesc{D, 512, D, 8}, S, E); }
        SEAM(pb + 8);
    }
    if (EN(17) && IN(41)) norm_phase<3, false>(F, p, x_in, ctx_adj, X, T_LAT, p.in[I_FG], nullptr, nullptr, 0, p.out);
#undef IN
#undef EN
#undef SEAM
}

extern "C" void kernel_launch(void* const* d_in, const int* in_sizes, int n_in, void* d_out, int out_size, void* d_ws, size_t ws_size, hipStream_t stream) {
    static int ready = 0;
    if (ready == 0) {
        if (n_in != 33 || out_size != T_LAT * D || ws_size < WS_END + (REP_MASK ? (size_t)T_ALL * D * 2 : 0)) { fprintf(stderr, "kernel_launch: unexpected shapes (n_in %d out %d ws %zu need %zu)\n", n_in, out_size, ws_size, (size_t)WS_END); ready = -1; return; }
        if (hipFuncSetAttribute((const void*)mega, hipFuncAttributeMaxDynamicSharedMemorySize, LDS_BYTES) != hipSuccess) { fprintf(stderr, "kernel_launch: hipFuncSetAttribute failed\n"); ready = -1; return; }
        int per_cu = 0; (void)hipOccupancyMaxActiveBlocksPerMultiprocessor(&per_cu, (const void*)mega, NTHR, LDS_BYTES); (void)hipGetLastError();
        if (per_cu < 1) fprintf(stderr, "kernel_launch: occupancy query reports %d\n", per_cu);
        ready = 1;
    }
    if (ready < 0) return;
    (void)hipMemsetAsync((char*)d_ws + WS_CTL, 0, CTL_BYTES, stream);
    Params p{};
    for (int i = 0; i < 33; ++i) p.in[i] = (const float*)d_in[i];
    p.out = (float*)d_out; p.ws = (unsigned char*)d_ws;
#if MK_ONE_LAUNCH
    p.ph_lo = 0; p.ph_hi = 42;
    hipLaunchKernelGGL(mega, dim3(NWG), dim3(NTHR), LDS_BYTES, stream, p);
#else
    for (int ph = 0; ph < 42; ++ph) {
        const int l = (ph - 1) / 10, k = (ph - 1) % 10;
        if (ph >= 1 && ph <= 40) { const int kind = l % 3; if (k == 9 || (kind != 2 && k == 4)) continue; }
        p.ph_lo = ph; p.ph_hi = ph + 1;
        hipLaunchKernelGGL(mega, dim3(NWG), dim3(NTHR), LDS_BYTES, stream, p);
    }
#endif
}
```

```cpp
#include <hip/hip_runtime.h>
#include <cstdio>
#include <cstdint>

#ifndef MK_NAIVE
#define MK_NAIVE 0
#endif
#ifndef MK_ALIGN_EPI
#define MK_ALIGN_EPI 1
#endif
#ifndef MK_ONE_LAUNCH
#define MK_ONE_LAUNCH 1
#endif

#define LAS __attribute__((address_space(3)))
typedef unsigned short bf16_t;
typedef short bf16x8 __attribute__((ext_vector_type(8)));
typedef float f32x4 __attribute__((ext_vector_type(4)));
typedef float f32x2 __attribute__((ext_vector_type(2)));
typedef unsigned u32x4 __attribute__((ext_vector_type(4)));
typedef unsigned u32x2 __attribute__((ext_vector_type(2)));
typedef int i32x4 __attribute__((ext_vector_type(4)));

constexpr int D = 1024, NB = 32, SEQ = 2048, LCTX = 256, DEPTH = 4;
constexpr int T_LAT = NB * SEQ, T_CTX = NB * LCTX, T_ALL = T_LAT + T_CTX;
constexpr int NMOD = NB + 1, MODW = 6 * D;
constexpr int NBUCKET = 112, SLOTS_MAX = T_ALL + NBUCKET * 256;
constexpr int NCHUNK = T_ALL / 32;
constexpr int AGLD = 768;
constexpr int NWG = 256, NTHR = 512;

constexpr size_t al256(size_t x) { return (x + 255) & ~(size_t)255; }
constexpr size_t WS_CTL = 0;
constexpr size_t CTL_BYTES = 65536;
constexpr size_t WS_MOD = WS_CTL + CTL_BYTES;
constexpr size_t WS_MODG = al256(WS_MOD + (size_t)DEPTH * NMOD * MODW * 4);
constexpr size_t WS_A32 = al256(WS_MODG + (size_t)DEPTH * 2 * NMOD * D * 2);
constexpr size_t WS_X = al256(WS_A32 + 64 * 2 * 64 * 8);
constexpr size_t WS_H = al256(WS_X + (size_t)(T_ALL + 1) * D * 2);
constexpr size_t WS_T1 = al256(WS_H + (size_t)T_ALL * D * 2);
constexpr size_t T1_BYTES = (size_t)64 * NCHUNK * AGLD * 2;
constexpr size_t WS_T2 = al256(WS_T1 + T1_BYTES);
constexpr size_t T2_BYTES = (size_t)SLOTS_MAX * D * 2;
constexpr size_t WS_T3 = al256(WS_T2 + T2_BYTES);
constexpr size_t WS_TOK = al256(WS_T3 + (size_t)T_ALL * D * 2);
constexpr size_t WS_CNT = al256(WS_TOK + (size_t)T_ALL * 16);
constexpr size_t WS_PERM = al256(WS_CNT + 256 * NBUCKET * 4);
constexpr size_t WS_SLOTW = al256(WS_PERM + (size_t)SLOTS_MAX * 4);
constexpr size_t WS_TILE = al256(WS_SLOTW + (size_t)SLOTS_MAX * 8);
constexpr size_t WS_WCIN = al256(WS_TILE + 4096);
constexpr size_t WS_WCOUT = al256(WS_WCIN + (size_t)2 * 2048 * 1024 * 2);
constexpr size_t WS_WSIN = al256(WS_WCOUT + (size_t)2 * 1024 * 1024 * 2);
constexpr size_t WS_WSOUT = al256(WS_WSIN + (size_t)3072 * 1024 * 2);
constexpr size_t WS_WGLU = al256(WS_WSOUT + (size_t)1024 * 1024 * 2);
constexpr size_t WS_W13 = al256(WS_WGLU + (size_t)2048 * 1024 * 2);
constexpr size_t WS_W2 = al256(WS_W13 + (size_t)128 * 1024 * 1024 * 2);
constexpr size_t WS_S5WS = al256(WS_W2 + (size_t)128 * 1024 * 512 * 2);
constexpr size_t WS_S5WT = al256(WS_S5WS + (size_t)64 * 256 * 512 * 2);
constexpr size_t WS_END = al256(WS_S5WT + (size_t)64 * 512 * 768 * 2);
constexpr size_t CTL_QUEUE = 16384;
static_assert(T1_BYTES >= (size_t)SLOTS_MAX * D * 2 && T2_BYTES >= (size_t)64 * NCHUNK * 256 * 4, "aliases");

constexpr int LDS_SCRATCH = 147456;
constexpr int LDS_MISC = LDS_SCRATCH;
constexpr int LDS_BARW = LDS_SCRATCH + 4096;
constexpr int LDS_BYTES = LDS_SCRATCH + 4096 + 64;

__device__ __forceinline__ unsigned cvt_pk_bf16(float lo, float hi) { unsigned r; asm volatile("v_cvt_pk_bf16_f32 %0, %1, %2" : "=v"(r) : "v"(lo), "v"(hi)); return r; }
__device__ __forceinline__ float bf_lo(unsigned u) { return __uint_as_float(u << 16); }
__device__ __forceinline__ float bf_hi(unsigned u) { return __uint_as_float(u & 0xffff0000u); }
__device__ __forceinline__ float fast_sigmoid(float x) { return __builtin_amdgcn_rcpf(1.0f + __expf(-x)); }
__device__ __forceinline__ float wave_allsum(float v) {
    v += __shfl_xor(v, 32); v += __shfl_xor(v, 16); v += __shfl_xor(v, 8); v += __shfl_xor(v, 4); v += __shfl_xor(v, 2); v += __shfl_xor(v, 1); return v; }
__device__ __forceinline__ void wave_sum4(float (&v)[4], int lane) {
    const bool u5 = (lane & 32) != 0, u4 = (lane & 16) != 0;
    float r0 = (u5 ? v[2] : v[0]) + __shfl_xor(u5 ? v[0] : v[2], 32), r1 = (u5 ? v[3] : v[1]) + __shfl_xor(u5 ? v[1] : v[3], 32);
    float s = (u4 ? r1 : r0) + __shfl_xor(u4 ? r0 : r1, 16);
    s += __shfl_xor(s, 8); s += __shfl_xor(s, 4); s += __shfl_xor(s, 2); s += __shfl_xor(s, 1);
#pragma unroll
    for (int i = 0; i < 4; ++i) v[i] = __int_as_float(__builtin_amdgcn_readlane(__float_as_int(s), 16 * i));
}
__device__ __forceinline__ void wave_sum8(float (&v)[8], int lane) {
    const bool u5 = (lane & 32) != 0, u4 = (lane & 16) != 0, u3 = (lane & 8) != 0;
    float a[4];
#pragma unroll
    for (int i = 0; i < 4; ++i) a[i] = (u5 ? v[4 + i] : v[i]) + __shfl_xor(u5 ? v[i] : v[4 + i], 32);
    float b0 = (u4 ? a[2] : a[0]) + __shfl_xor(u4 ? a[0] : a[2], 16), b1 = (u4 ? a[3] : a[1]) + __shfl_xor(u4 ? a[1] : a[3], 16);
    float s = (u3 ? b1 : b0) + __shfl_xor(u3 ? b0 : b1, 8);
    s += __shfl_xor(s, 4); s += __shfl_xor(s, 2); s += __shfl_xor(s, 1);
#pragma unroll
    for (int i = 0; i < 8; ++i) v[i] = __int_as_float(__builtin_amdgcn_readlane(__float_as_int(s), 8 * i));
}
__device__ __forceinline__ int modrow_of(int row) { return row < T_LAT ? (row >> 11) : NB; }

struct Frame { LAS unsigned char* lds; int tid, lane, wave, G, bid; };
__device__ __forceinline__ Frame phase_frame(LAS unsigned char* lds) {
    Frame F; int t = threadIdx.x; asm volatile("" : "+v"(t)); F.lds = lds; F.tid = t; F.lane = t & 63; F.wave = __builtin_amdgcn_readfirstlane(t >> 6); F.G = gridDim.x; F.bid = blockIdx.x; return F; }

#define XB_TMO      128
#define XB_XCNT(j)  (256  + 64 * (j))
#define XB_XSUB(j)  (1280 + 64 * (j))
#define XB_XGEN(j)  (2304 + 64 * (j))
#define XB_TOP      3328
#define XB_TOPGEN   3392
#define XCD_BAR_WORDS 3456
#define XB_SPIN_CAP (1u << 20)
__device__ __forceinline__ unsigned xb_ld(unsigned* p)              { return __hip_atomic_load(p, __ATOMIC_RELAXED, __HIP_MEMORY_SCOPE_AGENT); }
__device__ __forceinline__ unsigned xb_add(unsigned* p, unsigned v) { return __hip_atomic_fetch_add(p, v, __ATOMIC_RELAXED, __HIP_MEMORY_SCOPE_AGENT); }
__device__ __forceinline__ unsigned xb_xcc_id() { return (unsigned)__builtin_amdgcn_s_getreg((3 << 11) | 20) & 0xFu; }
#define XB_SPIN(cond, bar) do { unsigned _sp = 0; while (cond) { __builtin_amdgcn_s_sleep(1); \
    if ((++_sp & 255u) == 0u) { if (xb_ld(&(bar)[XB_TMO])) break; if (_sp > XB_SPIN_CAP) { atomicAdd(&(bar)[XB_TMO], 1u); break; } } } } while (0)
struct XcdBarrier { unsigned* bar; unsigned x; volatile LAS unsigned* st; };
__device__ __forceinline__ XcdBarrier xcd_barrier_post(unsigned* bar, volatile LAS unsigned* st) {
    XcdBarrier b; b.bar = bar; b.x = xb_xcc_id(); b.st = st;
    if (threadIdx.x == 0) (void)xb_add(&bar[XB_XCNT(b.x)], 1u);
    return b;
}
__device__ __forceinline__ void xcd_barrier_complete(unsigned* bar, unsigned x, unsigned& nloc, unsigned& nx) {
    const unsigned G = gridDim.x * gridDim.y * gridDim.z;
    unsigned sum, cnt, mine, sp = 0u;
    for (;;) {
        sum = 0u; cnt = 0u; mine = 0u;
#pragma unroll
        for (unsigned j = 0; j < 16; ++j) { const unsigned c = xb_ld(&bar[XB_XCNT(j)]); sum += c; cnt += (c > 0u) ? 1u : 0u; mine = (j == x) ? c : mine; }
        if (sum == G) break;
        __builtin_amdgcn_s_sleep(1);
        if ((++sp & 255u) == 0u) { if (xb_ld(&bar[XB_TMO])) break; if (sp > XB_SPIN_CAP) { atomicAdd(&bar[XB_TMO], 1u); break; } }
    }
    nloc = mine > 0u ? mine : 1u; nx = cnt > 0u ? cnt : 1u;
}
__device__ __forceinline__ void xcd_barrier(const XcdBarrier& b) {
    asm volatile("s_waitcnt vmcnt(0)" ::: "memory");
    __syncthreads();
    if (threadIdx.x == 0) {
        unsigned* bar = b.bar;
        __builtin_amdgcn_s_waitcnt(0);
        unsigned nloc = b.st[0], nx = b.st[1];
        if (nloc == 0u) { xcd_barrier_complete(bar, b.x, nloc, nx); b.st[0] = nloc; b.st[1] = nx; }
        const unsigned old = xb_add(&bar[XB_XSUB(b.x)], 1u);
        const unsigned gen = old / nloc;
        if (old + 1u == (gen + 1u) * nloc) {
            __builtin_amdgcn_fence(__ATOMIC_RELEASE, "agent");
            asm volatile("s_waitcnt vmcnt(0)" ::: "memory");
            const unsigned og = xb_add(&bar[XB_TOP], 1u);
            const unsigned tg = og / nx;
            if (og + 1u == (tg + 1u) * nx) xb_add(&bar[XB_TOPGEN], 1u);
            else XB_SPIN(xb_ld(&bar[XB_TOPGEN]) == tg, bar);
            __builtin_amdgcn_fence(__ATOMIC_ACQUIRE, "agent");
            xb_add(&bar[XB_XGEN(b.x)], 1u);
            asm volatile("s_waitcnt vmcnt(0)" ::: "memory");
        } else {
            XB_SPIN(xb_ld(&bar[XB_XGEN(b.x)]) == gen, bar);
            __builtin_amdgcn_fence(__ATOMIC_ACQUIRE, "agent");
            asm volatile("s_waitcnt vmcnt(0)" ::: "memory");
        }
    }
    __syncthreads();
}

namespace pg8 {
constexpr int BM = 256, BK = 64, HALF = 128, HTB = HALF * BK * 2, STAGE_BYTES = 8 * HTB, NXCD = 8, WGM = 8;
__host__ __device__ __forceinline__ int lds_byte(int r, int c) { const int st = (r >> 4) * 2 + (c >> 5), rr = r & 15, cc = c & 31, ob = rr * 64 + cc * 2; return st * 1024 + (ob ^ (((ob >> 9) & 1) << 5)); }
__host__ __device__ __forceinline__ void stage_rc(int b, int& R, int& C) { const int st = b / 1024, sb = b % 1024, swz = sb ^ (((sb >> 9) & 1) << 5); R = (st >> 1) * 16 + swz / 64; C = (st & 1) * 32 + (swz % 64) / 2; }
__host__ __device__ __forceinline__ int perm32(int rho) { const int n = rho >> 4, i = rho & 15; return 8 * (i >> 2) + 4 * n + (i & 3); }

struct Unit { int pm, pn, pb; const char* a; const char* b; const char* b1; };
struct GemmDesc { int lda, ldb, K, ksplit; };

#if MK_NAIVE
template <class Epi, class Sched>
__device__ __forceinline__ void gemm_phase(LAS unsigned char* lds, const GemmDesc g, const Sched& S, const Epi& E) {
    int tid_ = threadIdx.x; asm volatile("" : "+v"(tid_));
    const int tid = tid_, wid = tid >> 6, lane = tid & 63, wr = wid >> 2, wc = wid & 3, fr = lane & 15, fq = lane >> 4;
    const int nt = g.K / BK;
    LAS unsigned* As = (LAS unsigned*)lds;
    LAS unsigned* Bs = (LAS unsigned*)(lds + 256 * 33 * 4);
    Unit u;
    for (int ui = 0; S.next(ui, u); ++ui) {
        f32x4 acc[2][2][4][2];
#pragma unroll
        for (int a = 0; a < 2; ++a)
#pragma unroll
            for (int b = 0; b < 2; ++b)
#pragma unroll
                for (int m = 0; m < 4; ++m)
#pragma unroll
                    for (int n = 0; n < 2; ++n) acc[a][b][m][n] = (f32x4){0.f, 0.f, 0.f, 0.f};
#pragma unroll 1
        for (int kt = 0; kt < nt; ++kt) {
            __syncthreads();
            const char* bsrc = (kt < g.ksplit) ? u.b : u.b1;
#pragma unroll
            for (int i = 0; i < 4; ++i) {
                const int piece = tid + i * 512, r = piece >> 3, cq = piece & 7;
                size_t arow = r; if constexpr (Sched::GATHER) arow = S.row_of(u, r);
                const u32x4 va = *(const u32x4*)(u.a + (arow * g.lda) * 2 + (size_t)kt * 128 + cq * 16);
                const u32x4 vb = *(const u32x4*)(bsrc + ((size_t)r * g.ldb) * 2 + (size_t)kt * 128 + cq * 16);
                As[r * 33 + cq * 4 + 0] = va.x; As[r * 33 + cq * 4 + 1] = va.y; As[r * 33 + cq * 4 + 2] = va.z; As[r * 33 + cq * 4 + 3] = va.w;
                Bs[r * 33 + cq * 4 + 0] = vb.x; Bs[r * 33 + cq * 4 + 1] = vb.y; Bs[r * 33 + cq * 4 + 2] = vb.z; Bs[r * 33 + cq * 4 + 3] = vb.w;
            }
            __syncthreads();
#pragma unroll 1
            for (int k2 = 0; k2 < 32; ++k2) {
                float a0[2][4], a1[2][4];
#pragma unroll
                for (int ai = 0; ai < 2; ++ai)
#pragma unroll
                    for (int m = 0; m < 4; ++m) { const unsigned v = As[(ai * 128 + wr * 64 + m * 16 + fr) * 33 + k2]; a0[ai][m] = bf_lo(v); a1[ai][m] = bf_hi(v); }
#pragma unroll
                for (int bj = 0; bj < 2; ++bj)
#pragma unroll
                    for (int n = 0; n < 2; ++n)
#pragma unroll
                        for (int j = 0; j < 4; ++j) {
                            const unsigned v = Bs[(bj * 128 + wc * 32 + fq * 8 + n * 4 + j) * 33 + k2]; const float b0 = bf_lo(v), b1 = bf_hi(v);
#pragma unroll
                            for (int ai = 0; ai < 2; ++ai)
#pragma unroll
                                for (int m = 0; m < 4; ++m) acc[ai][bj][m][n][j] += a0[ai][m] * b0 + a1[ai][m] * b1;
                        }
            }
        }
        E(acc, u, wr, wc, fr, fq);
    }
    __syncthreads();
}
#else
template <class Epi, class Sched>
__device__ __forceinline__ void gemm_phase(LAS unsigned char* lds, const GemmDesc g, const Sched& S, const Epi& E) {
    int tid_ = threadIdx.x; asm volatile("" : "+v"(tid_));
    const int tid = tid_, wid = __builtin_amdgcn_readfirstlane(tid >> 6), lane = tid & 63, wr = wid >> 2, wc = wid & 3, fr = lane & 15, fq = lane >> 4;
    const int nt = g.K / BK, ksplit = g.ksplit;
    unsigned voffB[2]; int Rv[2], Cv[2];
#pragma unroll
    for (int i = 0; i < 2; ++i) { int R, C; stage_rc(tid * 16 + i * 8192, R, C); const int Rb = (R & ~31) + perm32(R & 31);
        Rv[i] = R; Cv[i] = C; voffB[i] = (unsigned)(Rb * g.ldb + C) * 2u; }
    unsigned va[2][2], vn[2][2];
#define PG8_SETV(v, un) do { _Pragma("unroll") for (int _h = 0; _h < 2; ++_h) _Pragma("unroll") for (int _i = 0; _i < 2; ++_i) { \
        if constexpr (Sched::GATHER) (v)[_h][_i] = (unsigned)S.row_of((un), _h * HALF + Rv[_i]) * (unsigned)(g.lda * 2) + (unsigned)(Cv[_i] * 2); \
        else (v)[_h][_i] = (unsigned)((_h * HALF + Rv[_i]) * g.lda + Cv[_i]) * 2u; } } while (0)
    const size_t kstep = (size_t)(BK * 2);
    const size_t hstepB = (size_t)HALF * g.ldb * 2;
    const unsigned ldsw = (unsigned)wid * 1024u;
    const int aoff = lds_byte(wr * 64 + fr, fq * 8), boff = lds_byte(wc * 32 + fr, fq * 8);
#define PG8_SA(b, h) (((b) * 2 + (h)) * HTB)
#define PG8_SB(b, h) ((4 + (b) * 2 + (h)) * HTB)
#define PG8_STAGE(bufoff, gbase, voff) do { _Pragma("unroll") for (int _i = 0; _i < 2; ++_i) \
        __builtin_amdgcn_global_load_lds((const unsigned*)((const char*)(gbase) + (voff)[_i]), (LAS unsigned*)(lds + (bufoff) + ldsw + _i * 8192), 16, 0, 0); } while (0)
#define PG8_STAGEA(bufoff, gbase, h, nx) do { _Pragma("unroll") for (int _i = 0; _i < 2; ++_i) { const unsigned _o = (nx) ? vn[h][_i] : va[h][_i]; \
        __builtin_amdgcn_global_load_lds((const unsigned*)((const char*)(gbase) + _o), (LAS unsigned*)(lds + (bufoff) + ldsw + _i * 8192), 16, 0, 0); } } while (0)
#define PG8_LDA(dst, b, h) do { _Pragma("unroll") for (int m = 0; m < 4; ++m) _Pragma("unroll") for (int k = 0; k < 2; ++k) dst[m][k] = *(const LAS bf16x8*)(lds + PG8_SA(b, h) + aoff + m * 2048 + k * 1024); } while (0)
#define PG8_LDB(dst, b, h) do { _Pragma("unroll") for (int n = 0; n < 2; ++n) _Pragma("unroll") for (int k = 0; k < 2; ++k) dst[n][k] = *(const LAS bf16x8*)(lds + PG8_SB(b, h) + boff + n * 2048 + k * 1024); } while (0)
#define PG8_MMA(ai, bj, At, Bt) do { __builtin_amdgcn_s_setprio(1); _Pragma("unroll") for (int m = 0; m < 4; ++m) _Pragma("unroll") for (int n = 0; n < 2; ++n) _Pragma("unroll") for (int k = 0; k < 2; ++k) \
        acc[ai][bj][m][n] = __builtin_amdgcn_mfma_f32_16x16x32_bf16(Bt[n][k], At[m][k], acc[ai][bj][m][n], 0, 0, 0); __builtin_amdgcn_s_setprio(0); } while (0)
#define PG8_WAIT_V(n) asm volatile("s_waitcnt vmcnt(" #n ")" ::: "memory")
#define PG8_WAIT_L(n) asm volatile("s_waitcnt lgkmcnt(" #n ")" ::: "memory")
#define PG8_BAR __builtin_amdgcn_s_barrier()
#define PG8_SCHED __builtin_amdgcn_sched_barrier(0)
    Unit cur, nxt; int ui = 0;
    if (!S.next(0, cur)) return;
    f32x4 acc[2][2][4][2];
#pragma unroll
    for (int a = 0; a < 2; ++a)
#pragma unroll
        for (int b = 0; b < 2; ++b)
#pragma unroll
            for (int m = 0; m < 4; ++m)
#pragma unroll
                for (int n = 0; n < 2; ++n) acc[a][b][m][n] = (f32x4){0.f, 0.f, 0.f, 0.f};
    bf16x8 At[4][2], B0[2][2], B1[2][2];
    const char* cA = cur.a; const char* cB = cur.b; const char* cB1 = cur.b1;
    PG8_SETV(va, cur);
#pragma unroll
    for (int _h = 0; _h < 2; ++_h)
#pragma unroll
        for (int _i = 0; _i < 2; ++_i) vn[_h][_i] = va[_h][_i];
    PG8_STAGE(PG8_SB(0, 0), cB, voffB); PG8_STAGE(PG8_SB(0, 1), cB + hstepB, voffB); PG8_STAGEA(PG8_SA(0, 0), cA, 0, false); PG8_STAGEA(PG8_SA(0, 1), cA, 1, false);
    if (wr == 1) PG8_BAR;
    PG8_WAIT_V(2); PG8_BAR;
    PG8_STAGE(PG8_SB(1, 0), cB + kstep, voffB); PG8_STAGEA(PG8_SA(1, 0), cA + kstep, 0, false); PG8_STAGE(PG8_SB(1, 1), cB + hstepB + kstep, voffB);
    PG8_WAIT_V(6); PG8_BAR;
    for (;;) {
        const bool has_next = S.next(ui + 1, nxt);
        const char* nA = has_next ? nxt.a : cA; const char* nB = has_next ? nxt.b : cB;
        if (has_next) { PG8_SETV(vn, nxt); }
        for (int t = 0; t < nt; t += 2) {
            const bool last = (t == nt - 2);
            const char* a1 = cA + (size_t)(t + 1) * kstep;
            const char* bsel = (t + 2 < ksplit) ? cB : cB1;
            const char* a2 = last ? nA : cA + (size_t)(t + 2) * kstep; const char* b2 = last ? nB : bsel + (size_t)(t + 2) * kstep;
            const char* a3 = a2 + kstep; const char* b3 = b2 + kstep;
            PG8_LDB(B0, 0, 0); PG8_LDB(B1, 0, 1); PG8_SCHED; PG8_LDA(At, 0, 0); PG8_STAGEA(PG8_SA(1, 1), a1, 1, false);
            PG8_WAIT_V(8); PG8_WAIT_L(0); PG8_BAR; PG8_MMA(0, 0, At, B0); PG8_MMA(0, 1, At, B1); PG8_BAR; PG8_SCHED;
            PG8_LDA(At, 0, 1); PG8_STAGE(PG8_SB(0, 0), b2, voffB); PG8_STAGE(PG8_SB(0, 1), b2 + hstepB, voffB); PG8_STAGEA(PG8_SA(0, 0), a2, 0, last);
            PG8_WAIT_V(8); PG8_WAIT_L(0); PG8_BAR; PG8_MMA(1, 0, At, B0); PG8_MMA(1, 1, At, B1); PG8_BAR; PG8_SCHED;
            PG8_LDB(B0, 1, 0); PG8_LDB(B1, 1, 1); PG8_SCHED; PG8_LDA(At, 1, 0); PG8_STAGEA(PG8_SA(0, 1), a2, 1, last);
            PG8_WAIT_V(8); PG8_WAIT_L(0); PG8_BAR; PG8_MMA(0, 0, At, B0); PG8_MMA(0, 1, At, B1); PG8_BAR; PG8_SCHED;
            PG8_LDA(At, 1, 1); PG8_STAGE(PG8_SB(1, 0), b3, voffB); PG8_STAGE(PG8_SB(1, 1), b3 + hstepB, voffB); PG8_STAGEA(PG8_SA(1, 0), a3, 0, last);
            PG8_WAIT_V(8); PG8_WAIT_L(0); PG8_BAR; PG8_MMA(1, 0, At, B0); PG8_MMA(1, 1, At, B1); PG8_BAR; PG8_SCHED;
        }
#if MK_ALIGN_EPI
        if (wr == 0) PG8_BAR;
#endif
        E(acc, cur, wr, wc, fr, fq);
        if (!has_next) break;
#pragma unroll
        for (int a = 0; a < 2; ++a)
#pragma unroll
            for (int b = 0; b < 2; ++b)
#pragma unroll
                for (int m = 0; m < 4; ++m)
#pragma unroll
                    for (int n = 0; n < 2; ++n) acc[a][b][m][n] = (f32x4){0.f, 0.f, 0.f, 0.f};
        cur = nxt; cA = nA; cB = nB; cB1 = nxt.b1; ++ui;
#pragma unroll
        for (int _h = 0; _h < 2; ++_h)
#pragma unroll
            for (int _i = 0; _i < 2; ++_i) va[_h][_i] = vn[_h][_i];
#if MK_ALIGN_EPI
        if (wr == 1) PG8_BAR;
#endif
    }
    PG8_WAIT_V(0);
#if !MK_ALIGN_EPI
    if (wr == 0) PG8_BAR;
#endif
    PG8_BAR;
#undef PG8_SA
#undef PG8_SB
#undef PG8_STAGE
#undef PG8_STAGEA
#undef PG8_SETV
#undef PG8_LDA
#undef PG8_LDB
#undef PG8_MMA
#undef PG8_WAIT_V
#undef PG8_WAIT_L
#undef PG8_BAR
#undef PG8_SCHED
}
#endif

struct DenseOrder {
    static constexpr bool GATHER = false;
    int same = 0;
    const char* A; const char* Bt; size_t strideA, strideB; int lda, ldb, nM, nN, nB, ntot, G, c;
    __device__ void init(const void* A_, const void* Bt_, int M, int N, int lda_, int ldb_, int nB_, size_t sA, size_t sB, int G_, int c_) {
        A = (const char*)A_; Bt = (const char*)Bt_; lda = lda_; ldb = ldb_; nM = M / BM; nN = N / BM; nB = nB_; ntot = nM * nN * nB; strideA = sA; strideB = sB; G = G_; c = c_; }
    __device__ __forceinline__ bool next(int i, Unit& u) const {
        const int L = i * G + c; if (L >= ntot) return false;
        int wgid = L; { const int q = ntot / NXCD, r = ntot % NXCD, xcd = wgid % NXCD, off = wgid / NXCD; wgid = (xcd < r ? xcd * (q + 1) : r * (q + 1) + (xcd - r) * q) + off; }
        const int per = nM * nN, pb = wgid / per, rem = wgid % per;
        const int nig = WGM * nN, gid = rem / nig, fm = gid * WGM, gsz = (nM - fm) < WGM ? (nM - fm) : WGM;
        u.pm = fm + ((rem % nig) % gsz); u.pn = (rem % nig) / gsz; u.pb = pb;
        u.a = A + (size_t)pb * strideA + (size_t)u.pm * BM * lda * 2; u.b = Bt + (size_t)pb * strideB + (size_t)u.pn * BM * ldb * 2; u.b1 = u.b;
        if (same) { u.a = A; u.b = Bt; u.b1 = Bt; }
        return true;
    }
};
template <int WHICH  > struct MoeOrder {
    static constexpr bool GATHER = (WHICH == 1);
    const char* A; const char* W; const LAS int* tile; const int* perm; int n_mt, nN, ntot, G, c;
    __device__ __forceinline__ int row_of(const Unit& u, int r) const { const int t = perm[u.pm * BM + r]; return t < 0 ? 0 : t; }
    __device__ void init(const void* A_, const void* W_, const LAS int* tile_, const int* perm_, int G_, int c_) {
        A = (const char*)A_; W = (const char*)W_; tile = tile_; perm = perm_; G = G_; c = c_;
        n_mt = __builtin_amdgcn_readfirstlane(tile[0]);
        nN = (WHICH == 1) ? 8 : 4; ntot = n_mt * nN; }
    __device__ __forceinline__ bool next(int i, Unit& u) const {
        const int L = i * G + c; if (L >= ntot) return false;
        int wgid = L; { const int q = ntot / NXCD, r = ntot % NXCD, xcd = wgid % NXCD, off = wgid / NXCD; wgid = (xcd < r ? xcd * (q + 1) : r * (q + 1) + (xcd - r) * q) + off; }
        const int mt = wgid / nN, pn = wgid % nN;
        const int ee = __builtin_amdgcn_readfirstlane(tile[16 + mt]);
        const int elo = ee & 255, ehi = (ee >> 8) & 255;
        u.pm = mt; u.pn = pn; u.pb = 0;
        u.a = (WHICH == 1) ? A : A + (size_t)mt * BM * D * 2;
        if (WHICH == 1) { const int e = (pn < 4) ? elo : ehi; u.b = W + (size_t)e * 1024 * 1024 * 2 + (size_t)(pn & 3) * BM * 1024 * 2; u.b1 = u.b; }
        else { u.b = W + (size_t)elo * 1024 * 512 * 2 + (size_t)pn * BM * 512 * 2; u.b1 = W + (size_t)ehi * 1024 * 512 * 2 + (size_t)pn * BM * 512 * 2 - 8 * 128; }
        return true;
    }
};

#define EPI_ARGS const f32x4 (&acc)[2][2][4][2], const Unit& u, int wr, int wc, int fr, int fq
#define EPI_ROW(ai, m) (u.pm * BM + (ai) * HALF + wr * 64 + (m) * 16 + fr)
__device__ __forceinline__ u32x4 pack8(const f32x4& a, const f32x4& b) { u32x4 w; w.x = cvt_pk_bf16(a[0], a[1]); w.y = cvt_pk_bf16(a[2], a[3]); w.z = cvt_pk_bf16(b[0], b[1]); w.w = cvt_pk_bf16(b[2], b[3]); return w; }

struct EpiGlu { bf16_t* Z;
    __device__ __forceinline__ void operator()(EPI_ARGS) const {
        const int ch = u.pn * 128 + wc * 32 + fq * 8;
#pragma unroll
        for (int ai = 0; ai < 2; ++ai)
#pragma unroll
            for (int m = 0; m < 4; ++m) { f32x4 o[2];
#pragma unroll
                for (int n = 0; n < 2; ++n)
#pragma unroll
                    for (int j = 0; j < 4; ++j) o[n][j] = acc[ai][0][m][n][j] * fast_sigmoid(acc[ai][1][m][n][j]);
                *(u32x4*)(Z + (size_t)EPI_ROW(ai, m) * D + ch) = pack8(o[0], o[1]); }
    }
};
__device__ __forceinline__ void unpack8(const u32x4& v, f32x4& a, f32x4& b) { a[0] = bf_lo(v.x); a[1] = bf_hi(v.x); a[2] = bf_lo(v.y); a[3] = bf_hi(v.y); b[0] = bf_lo(v.z); b[1] = bf_hi(v.z); b[2] = bf_lo(v.w); b[3] = bf_hi(v.w); }
template <bool F32SRC> struct EpiResid { const float* src_lat; const float* src_ctx_adj; bf16_t* X16; const bf16_t* gate16;
    __device__ __forceinline__ void operator()(EPI_ARGS) const {
        const int row0 = u.pm * BM; const float* src = (row0 < T_LAT) ? src_lat : src_ctx_adj; const bf16_t* gp = gate16 + (size_t)modrow_of(row0) * D;
        if (F32SRC) {
#pragma unroll
            for (int bj = 0; bj < 2; ++bj) { const int col = u.pn * BM + bj * HALF + wc * 32 + fq * 8;
                f32x4 g0, g1; unpack8(*(const u32x4*)(gp + col), g0, g1);
#pragma unroll
                for (int ai = 0; ai < 2; ++ai) { f32x4 x0[4], x1[4];
#pragma unroll
                    for (int m = 0; m < 4; ++m) { const size_t o = (size_t)EPI_ROW(ai, m) * D + col; x0[m] = *(const f32x4*)(src + o); x1[m] = *(const f32x4*)(src + o + 4); }
#pragma unroll
                    for (int m = 0; m < 4; ++m) *(u32x4*)(X16 + (size_t)EPI_ROW(ai, m) * D + col) = pack8(x0[m] + g0 * acc[ai][bj][m][0], x1[m] + g1 * acc[ai][bj][m][1]); } }
        } else { u32x4 xs[2][2][4], gg[2];
#pragma unroll
            for (int bj = 0; bj < 2; ++bj) { const int col = u.pn * BM + bj * HALF + wc * 32 + fq * 8; gg[bj] = *(const u32x4*)(gp + col);
#pragma unroll
                for (int ai = 0; ai < 2; ++ai)
#pragma unroll
                    for (int m = 0; m < 4; ++m) xs[bj][ai][m] = *(const u32x4*)(X16 + (size_t)EPI_ROW(ai, m) * D + col); }
#pragma unroll
            for (int bj = 0; bj < 2; ++bj) { const int col = u.pn * BM + bj * HALF + wc * 32 + fq * 8; f32x4 g0, g1; unpack8(gg[bj], g0, g1);
#pragma unroll
                for (int ai = 0; ai < 2; ++ai)
#pragma unroll
                    for (int m = 0; m < 4; ++m) { f32x4 x0, x1; unpack8(xs[bj][ai][m], x0, x1);
                        *(u32x4*)(X16 + (size_t)EPI_ROW(ai, m) * D + col) = pack8(x0 + g0 * acc[ai][bj][m][0], x1 + g1 * acc[ai][bj][m][1]); } } }
    }
};
struct EpiGluResid { bf16_t* X16; const bf16_t* gate16;
    __device__ __forceinline__ void operator()(EPI_ARGS) const {
        const int row0 = u.pm * BM; const int ch = u.pn * 128 + wc * 32 + fq * 8;
        const u32x4 gg = *(const u32x4*)(gate16 + (size_t)modrow_of(row0) * D + ch);
        u32x4 xs[2][4];
#pragma unroll
        for (int ai = 0; ai < 2; ++ai)
#pragma unroll
            for (int m = 0; m < 4; ++m) xs[ai][m] = *(const u32x4*)(X16 + (size_t)EPI_ROW(ai, m) * D + ch);
#pragma unroll
        for (int ai = 0; ai < 2; ++ai)
#pragma unroll
            for (int m = 0; m < 4; ++m) { f32x4 v[2], x0, x1, g0, g1;
                unpack8(xs[ai][m], x0, x1); unpack8(gg, g0, g1);
#pragma unroll
                for (int n = 0; n < 2; ++n)
#pragma unroll
                    for (int j = 0; j < 4; ++j) v[n][j] = acc[ai][0][m][n][j] * fast_sigmoid(acc[ai][1][m][n][j]);
                *(u32x4*)(X16 + (size_t)EPI_ROW(ai, m) * D + ch) = pack8(x0 + g0 * v[0], x1 + g1 * v[1]); }
    }
};
struct EpiSc { bf16_t* P; bf16_t* GB;
    __device__ __forceinline__ void operator()(EPI_ARGS) const {
        if (u.pn < 8) { const int ch = u.pn * 128 + wc * 32 + fq * 8;
#pragma unroll
            for (int ai = 0; ai < 2; ++ai)
#pragma unroll
                for (int m = 0; m < 4; ++m) *(u32x4*)(P + (size_t)EPI_ROW(ai, m) * D + ch) = pack8(acc[ai][0][m][0] * acc[ai][1][m][0], acc[ai][0][m][1] * acc[ai][1][m][1]);
        } else {
#pragma unroll
            for (int bj = 0; bj < 2; ++bj) { const int ch = (u.pn - 8) * BM + bj * HALF + wc * 32 + fq * 8;
#pragma unroll
                for (int ai = 0; ai < 2; ++ai)
#pragma unroll
                    for (int m = 0; m < 4; ++m) *(u32x4*)(GB + (size_t)EPI_ROW(ai, m) * D + ch) = pack8(acc[ai][bj][m][0], acc[ai][bj][m][1]); } }
    }
};
struct EpiSwiglu { bf16_t* ACT; const f32x2* slotw;
    __device__ __forceinline__ void operator()(EPI_ARGS) const {
        const int which = u.pn >> 2, ch = which * 512 + (u.pn & 3) * 128 + wc * 32 + fq * 8;
        float wv[2][4];
#pragma unroll
        for (int ai = 0; ai < 2; ++ai)
#pragma unroll
            for (int m = 0; m < 4; ++m) wv[ai][m] = ((const float*)slotw)[2 * EPI_ROW(ai, m) + which];
#pragma unroll
        for (int ai = 0; ai < 2; ++ai)
#pragma unroll
            for (int m = 0; m < 4; ++m) { const int slot = EPI_ROW(ai, m); const float w = wv[ai][m]; f32x4 o[2];
#pragma unroll
                for (int n = 0; n < 2; ++n)
#pragma unroll
                    for (int j = 0; j < 4; ++j) { const float a = acc[ai][0][m][n][j]; o[n][j] = w * a * fast_sigmoid(a) * acc[ai][1][m][n][j]; }
                *(u32x4*)(ACT + (size_t)slot * D + ch) = pack8(o[0], o[1]); }
    }
};
struct EpiMoeDown { bf16_t* X16; const int* perm; const bf16_t* gate16;
    __device__ __forceinline__ void operator()(EPI_ARGS) const {
        int tok[2][4];
#pragma unroll
        for (int ai = 0; ai < 2; ++ai)
#pragma unroll
            for (int m = 0; m < 4; ++m) tok[ai][m] = perm[EPI_ROW(ai, m)];
#pragma unroll
        for (int ai = 0; ai < 2; ++ai)
#pragma unroll
            for (int m = 0; m < 4; ++m) tok[ai][m] = tok[ai][m] < 0 ? T_ALL : tok[ai][m];
#pragma unroll
        for (int bj = 0; bj < 2; ++bj) { const int col = u.pn * BM + bj * HALF + wc * 32 + fq * 8;
#pragma unroll
            for (int ai = 0; ai < 2; ++ai) { u32x4 xs[4], gs[4];
#pragma unroll
                for (int m = 0; m < 4; ++m) { xs[m] = *(const u32x4*)(X16 + (size_t)tok[ai][m] * D + col); gs[m] = *(const u32x4*)(gate16 + (size_t)modrow_of(tok[ai][m]) * D + col); }
#pragma unroll
                for (int m = 0; m < 4; ++m) { f32x4 x0, x1, g0, g1; unpack8(xs[m], x0, x1); unpack8(gs[m], g0, g1);
                    *(u32x4*)(X16 + (size_t)tok[ai][m] * D + col) = pack8(x0 + g0 * acc[ai][bj][m][0], x1 + g1 * acc[ai][bj][m][1]); } } }
    }
};
struct EpiS5State { float* S;
    __device__ __forceinline__ void operator()(EPI_ARGS) const {
#pragma unroll
        for (int bj = 0; bj < 2; ++bj) { const int col = bj * HALF + wc * 32 + fq * 8;
#pragma unroll
            for (int ai = 0; ai < 2; ++ai)
#pragma unroll
                for (int m = 0; m < 4; ++m) { float* o = S + ((size_t)u.pb * NCHUNK + EPI_ROW(ai, m)) * 256 + col;
                    *(f32x4*)o = acc[ai][bj][m][0]; *(f32x4*)(o + 4) = acc[ai][bj][m][1]; } }
    }
};
struct EpiS5Out { bf16_t* YG; const bf16_t* AG; const float* dvec;
    __device__ __forceinline__ void operator()(EPI_ARGS) const {
#pragma unroll
        for (int bj = 0; bj < 2; ++bj) { const int n = u.pn * BM + bj * HALF + wc * 32 + fq * 8, t = n >> 4, ch = u.pb * 16 + (n & 15);
            const f32x4 d0 = *(const f32x4*)(dvec + ch), d1 = *(const f32x4*)(dvec + ch + 4);
            u32x4 us[2][4];
#pragma unroll
            for (int ai = 0; ai < 2; ++ai)
#pragma unroll
                for (int m = 0; m < 4; ++m) us[ai][m] = *(const u32x4*)(AG + ((size_t)u.pb * NCHUNK + EPI_ROW(ai, m)) * AGLD + n);
#pragma unroll
            for (int ai = 0; ai < 2; ++ai)
#pragma unroll
                for (int m = 0; m < 4; ++m) { const int crow = EPI_ROW(ai, m); const u32x4 uu = us[ai][m];
                    f32x4 y0 = acc[ai][bj][m][0], y1 = acc[ai][bj][m][1];
                    y0[0] += d0[0] * bf_lo(uu.x); y0[1] += d0[1] * bf_hi(uu.x); y0[2] += d0[2] * bf_lo(uu.y); y0[3] += d0[3] * bf_hi(uu.y);
                    y1[0] += d1[0] * bf_lo(uu.z); y1[1] += d1[1] * bf_hi(uu.z); y1[2] += d1[2] * bf_lo(uu.w); y1[3] += d1[3] * bf_hi(uu.w);
#pragma unroll
                    for (int j = 0; j < 4; ++j) { const float a = y0[j], b = y1[j];
                        y0[j] = a * fast_sigmoid(1.5957691216f * (a + 0.044715f * a * a * a)); y1[j] = b * fast_sigmoid(1.5957691216f * (b + 0.044715f * b * b * b)); }
                    *(u32x4*)(YG + ((size_t)crow * 32 + t) * D + ch) = pack8(y0, y1); } }
    }
};
}

struct Params { const float* in[33]; float* out; unsigned char* ws; int ph_lo, ph_hi; };
enum { I_X = 0, I_C, I_CTX, I_CCTX, I_ADAW, I_ADAB, I_N1G, I_N2G, I_CWIN, I_CDW, I_CDWB, I_CLNG, I_CLNB, I_CWOUT, I_SWIN, I_SCONV, I_SWOUT,
       I_S5ARE, I_S5AIM, I_S5DT, I_S5BRE, I_S5BIM, I_S5CRE, I_S5CIM, I_S5D, I_S5WGLU, I_WG, I_BG, I_WE, I_BE, I_W13, I_W2, I_FG };

struct ConvJob { const float* src; bf16_t* dst; int K, N, mode, ntile_k, ntile_n, nmat; size_t sstride, dstride; };
__device__ __forceinline__ int conv_dst_row(int mode, int N, int n0) {
    if (mode == 0) return n0;
    if (mode == 1) { const int C = N >> 1, isg = n0 >= C, c = n0 - isg * C; return (c >> 7) * 256 + isg * 128; }
    if (n0 < 1024) return 2048 + n0;
    const int isg = n0 >= 2048, c = n0 - 1024 - isg * 1024; return (c >> 7) * 256 + isg * 128;
}
__device__ void convert_tile(const Frame& F, const ConvJob& J, int t) {
    const int per = J.ntile_k * J.ntile_n, mat = t / per, r = t % per, tk = r / J.ntile_n, tn = r % J.ntile_n;
    const float* src = J.src + (size_t)mat * J.sstride + (size_t)(tk * 64) * J.N + tn * 128;
    LAS unsigned* T = (LAS unsigned*)F.lds;
    __syncthreads();
#pragma unroll
    for (int i = 0; i < 2; ++i) { const int task = F.tid + i * 512, nq = task & 31, kp = task >> 5;
        const f32x4 r0 = *(const f32x4*)(src + (size_t)(2 * kp) * J.N + nq * 4), r1 = *(const f32x4*)(src + (size_t)(2 * kp + 1) * J.N + nq * 4);
#pragma unroll
        for (int j = 0; j < 4; ++j) T[(nq * 4 + j) * 33 + kp] = cvt_pk_bf16(r0[j], r1[j]); }
    __syncthreads();
    bf16_t* dst = J.dst + (size_t)mat * J.dstride + (size_t)conv_dst_row(J.mode, J.N, tn * 128) * J.K + tk * 64;
#pragma unroll
    for (int i = 0; i < 2; ++i) { const int task = F.tid + i * 512, q = task & 7, n = task >> 3;
        u32x4 v; v.x = T[n * 33 + q * 4]; v.y = T[n * 33 + q * 4 + 1]; v.z = T[n * 33 + q * 4 + 2]; v.w = T[n * 33 + q * 4 + 3];
        *(u32x4*)(dst + (size_t)n * J.K + q * 8) = v; }
}
__device__ __forceinline__ ConvJob make_job(const Params& p, int j) {
    ConvJob J; unsigned char* ws = p.ws;
    switch (j) {
    case 0: J = ConvJob{p.in[I_CWIN], (bf16_t*)(ws + WS_WCIN), 1024, 2048, 1, 16, 16, 2, (size_t)1024 * 2048, (size_t)2048 * 1024}; break;
    case 1: J = ConvJob{p.in[I_CWOUT], (bf16_t*)(ws + WS_WCOUT), 1024, 1024, 0, 16, 8, 2, (size_t)1024 * 1024, (size_t)1024 * 1024}; break;
    case 2: J = ConvJob{p.in[I_SWIN], (bf16_t*)(ws + WS_WSIN), 1024, 3072, 2, 16, 24, 1, 0, 0}; break;
    case 3: J = ConvJob{p.in[I_SWOUT], (bf16_t*)(ws + WS_WSOUT), 1024, 1024, 0, 16, 8, 1, 0, 0}; break;
    case 4: J = ConvJob{p.in[I_S5WGLU], (bf16_t*)(ws + WS_WGLU), 1024, 2048, 1, 16, 16, 1, 0, 0}; break;
    case 5: J = ConvJob{p.in[I_W13], (bf16_t*)(ws + WS_W13), 1024, 1024, 1, 16, 8, 128, (size_t)1024 * 1024, (size_t)1024 * 1024}; break;
    default: J = ConvJob{p.in[I_W2], (bf16_t*)(ws + WS_W2), 512, 1024, 0, 8, 8, 128, (size_t)512 * 1024, (size_t)1024 * 512}; break;
    }
    return J;
}
__device__ void mod_task(const Frame& F, const Params& p, int t) {
    const int layer = t / 96, n0 = (t % 96) * 64;
    const float* W = p.in[I_ADAW] + (size_t)layer * D * MODW; const float* bias = p.in[I_ADAB] + (size_t)layer * MODW;
    float* mod = (float*)(p.ws + WS_MOD) + (size_t)layer * NMOD * MODW;
    LAS float* sc = (LAS float*)F.lds;
    LAS float* red = (LAS float*)(F.lds + 33 * 512 * 4);
    float acc[NMOD];
#pragma unroll
    for (int r = 0; r < NMOD; ++r) acc[r] = 0.f;
    for (int half = 0; half < 2; ++half) {
        __syncthreads();
        for (int i = F.tid; i < NMOD * 512; i += NTHR) { const int r = i >> 9, k = (i & 511) + half * 512;
            const float v = (r < NB) ? p.in[I_C][r * D + k] : p.in[I_CCTX][k]; sc[i] = v * fast_sigmoid(v); }
        __syncthreads();
#pragma unroll 8
        for (int kk = 0; kk < 64; ++kk) { const int kl = F.wave * 64 + kk; const float w = W[(size_t)(half * 512 + kl) * MODW + n0 + F.lane];
#pragma unroll
            for (int r = 0; r < NMOD; ++r) acc[r] += sc[r * 512 + kl] * w; }
    }
#pragma unroll
    for (int r = 0; r < NMOD; ++r) red[(F.wave * NMOD + r) * 64 + F.lane] = acc[r];
    __syncthreads();
    for (int i = F.tid; i < NMOD * 64; i += NTHR) { const int r = i >> 6, l = i & 63; float s = bias[n0 + l];
#pragma unroll
        for (int w = 0; w < 8; ++w) s += red[(w * NMOD + r) * 64 + l];
        mod[(size_t)r * MODW + n0 + l] = s;
        const int chunk = n0 >> 10;
        if (chunk == 2 || chunk == 5) ((bf16_t*)(p.ws + WS_MODG))[((size_t)(layer * 2 + (chunk == 5)) * NMOD + r) * D + (n0 & 1023) + l] = (bf16_t)(cvt_pk_bf16(s, 0.f) & 0xffffu); }
    __syncthreads();
}
__device__ void s5_build(const Frame& F, const Params& p, int g) {
    LAS f32x2* P = (LAS f32x2*)F.lds;
    LAS f32x2* Bb = (LAS f32x2*)(F.lds + 33792);
    LAS f32x2* Cc = (LAS f32x2*)(F.lds + 33792 + 16384);
    LAS float* Kd = (LAS float*)(F.lds + 33792 + 32768);
    __syncthreads();
    if (F.tid < 128) { const int dir = F.tid >> 6, pp = F.tid & 63, gi = (dir * 64 + g) * 64 + pp;
        double are = (double)p.in[I_S5ARE][gi]; if (are > -1e-4) are = -1e-4; const double aim = (double)p.in[I_S5AIM][gi];
        const double dt = exp((double)p.in[I_S5DT][dir * 64 + g]);
        double ab_re = 0, ab_im = 0;
        for (int n = 0; n <= 32; ++n) { const double mag = exp(n * dt * are), ang = n * dt * aim, cr = mag * cos(ang), ci = mag * sin(ang);
            P[(dir * 64 + pp) * 33 + n] = (f32x2){(float)cr, (float)ci}; if (n == 1) { ab_re = cr; ab_im = ci; }
            if (n == 32) ((f32x2*)(p.ws + WS_A32))[(g * 2 + dir) * 64 + pp] = (f32x2){(float)cr, (float)ci}; }
        const double den = are * are + aim * aim, nre = ab_re - 1.0, nim = ab_im;
        const double kre = (nre * are + nim * aim) / den, kim = (nim * are - nre * aim) / den;
        for (int c = 0; c < 16; ++c) { const double br = (double)p.in[I_S5BRE][(size_t)gi * 16 + c], bi = (double)p.in[I_S5BIM][(size_t)gi * 16 + c];
            Bb[(dir * 64 + pp) * 16 + c] = (f32x2){(float)(kre * br - kim * bi), (float)(kre * bi + kim * br)}; }
        for (int c = 0; c < 16; ++c) { const size_t ci = ((size_t)(dir * 64 + g) * 16 + c) * 64 + pp;
            Cc[(dir * 16 + c) * 64 + pp] = (f32x2){p.in[I_S5CRE][ci], p.in[I_S5CIM][ci]}; }
    }
    __syncthreads();
    for (int e = F.tid; e < 2 * 32 * 256; e += NTHR) { const int dir = e >> 13, d = (e >> 8) & 31, c = (e >> 4) & 15, c2 = e & 15; float s = 0.f;
#pragma unroll 2
        for (int pp = 0; pp < 64; ++pp) { const f32x2 C = Cc[(dir * 16 + c) * 64 + pp], E = P[(dir * 64 + pp) * 33 + d], B = Bb[(dir * 64 + pp) * 16 + c2];
            const float er = E.x * B.x - E.y * B.y, ei = E.x * B.y + E.y * B.x; s += C.x * er - C.y * ei; }
        Kd[e] = s; }
    __syncthreads();
    unsigned* WT = (unsigned*)(p.ws + WS_S5WT) + (size_t)g * 512 * 384;
    for (int e = F.tid; e < 512 * 384; e += NTHR) { const int n = e / 384, k0 = (e % 384) * 2, t = n >> 4, c = n & 15; float v[2];
#pragma unroll
        for (int h = 0; h < 2; ++h) { const int k = k0 + h;
            if (k < 512) { const int s = k >> 4, c2 = k & 15;
                v[h] = (s < t) ? Kd[((0 * 32 + (t - s)) * 16 + c) * 16 + c2] : (s > t) ? Kd[((1 * 32 + (s - t)) * 16 + c) * 16 + c2] : (Kd[(c) * 16 + c2] + Kd[((32) * 16 + c) * 16 + c2]);
            } else { const int kk = k - 512, dir = kk >> 7, pp = (kk >> 1) & 63, ri = kk & 1;
                const f32x2 E = P[(dir * 64 + pp) * 33 + (dir == 0 ? t + 1 : 32 - t)], C = Cc[(dir * 16 + c) * 64 + pp];
                const float cr = C.x * E.x - C.y * E.y, ci = C.x * E.y + C.y * E.x; v[h] = ri ? -ci : cr; } }
        WT[e] = cvt_pk_bf16(v[0], v[1]); }
    unsigned* WSm = (unsigned*)(p.ws + WS_S5WS) + (size_t)g * 256 * 256;
    for (int e = F.tid; e < 256 * 256; e += NTHR) { const int n = e >> 8, k0 = (e & 255) * 2, dir = n >> 7, pp = (n >> 1) & 63, ri = n & 1; float v[2];
#pragma unroll
        for (int h = 0; h < 2; ++h) { const int k = k0 + h, s = k >> 4, c = k & 15;
            const f32x2 E = P[(dir * 64 + pp) * 33 + (dir == 0 ? 31 - s : s)], B = Bb[(dir * 64 + pp) * 16 + c];
            v[h] = ri ? (E.x * B.y + E.y * B.x) : (E.x * B.x - E.y * B.y); }
        WSm[e] = cvt_pk_bf16(v[0], v[1]); }
    __syncthreads();
}
__device__ __forceinline__ void prologue_phase(const Frame& F0, const Params& p) {
    const Frame F = phase_frame(F0.lds);
    if (F.bid < 64) s5_build(F, p, F.bid);
    else for (int t = F.bid - 64; t < 4 * 96; t += F.G - 64) mod_task(F, p, t);
    unsigned* qhead = (unsigned*)(p.ws + WS_CTL + CTL_QUEUE);
    LAS int* bc = (LAS int*)(F.lds + LDS_MISC);
    int jbase[8]; jbase[0] = 0;
#pragma unroll
    for (int j = 0; j < 7; ++j) { const ConvJob J = make_job(p, j); jbase[j + 1] = jbase[j] + J.ntile_k * J.ntile_n * J.nmat; }
    for (;;) {
        __syncthreads();
        if (F.tid == 0) bc[0] = (int)__hip_atomic_fetch_add(qhead, 1u, __ATOMIC_RELAXED, __HIP_MEMORY_SCOPE_AGENT);
        __syncthreads();
        const int t0 = bc[0] * 4;
        if (t0 >= jbase[7]) break;
        int j = 0;
#pragma unroll
        for (int k = 1; k < 7; ++k) if (t0 >= jbase[k]) j = k;
        const ConvJob J = make_job(p, j);
        int jb = 0;
#pragma unroll
        for (int k = 0; k < 7; ++k) if (k == j) jb = jbase[k];
        for (int t = t0; t < t0 + 4; ++t) convert_tile(F, J, t - jb);
    }
    __syncthreads();
}

template <int MODE, bool F32SRC>
__device__ __forceinline__ void norm_phase(const Frame& F0, const Params& p, const float* src_lat, const float* src_ctx_adj, const bf16_t* X16, int nrows, const float* gvec, const float* msc, const float* msh,
                           int layer, float* outf) {
    const Frame F = phase_frame(F0.lds);
    bf16_t* H = (bf16_t*)(p.ws + WS_H); bf16_t* AG = (bf16_t*)(p.ws + WS_T1);
    LAS int* lcnt = (LAS int*)(F.lds + LDS_MISC);
    LAS float* lbias = (LAS float*)(F.lds + LDS_MISC + 512);
    bf16x8 wh[4][3], wl[4][3];
    LAS unsigned char* stage = F.lds;
    LAS float* Pp = (LAS float*)(F.lds + 65536);
    LAS float* Lg = (LAS float*)(F.lds + 65536 + 24576);
    if (MODE == 2) {
        __syncthreads();
        const float* wg = p.in[I_WG] + (size_t)layer * D * 4; const float* we = p.in[I_WE] + (size_t)layer * D * 32;
        const int c = F.lane & 15, kq = F.lane >> 4;
#pragma unroll
        for (int si = 0; si < 4; ++si)
#pragma unroll
            for (int t = 0; t < 3; ++t) { float v[8];
#pragma unroll
                for (int j = 0; j < 8; ++j) { const int k = 32 * (4 * F.wave + si) + 8 * kq + j;
                    v[j] = (t == 0) ? (c < 4 ? wg[k * 4 + c] : 0.f) : we[k * 32 + (t - 1) * 16 + c]; }
                unsigned hi[4], lo[4];
#pragma unroll
                for (int j = 0; j < 4; ++j) { hi[j] = cvt_pk_bf16(v[2 * j], v[2 * j + 1]); lo[j] = cvt_pk_bf16(v[2 * j] - bf_lo(hi[j]), v[2 * j + 1] - bf_hi(hi[j])); }
                u32x4 h4 = {hi[0], hi[1], hi[2], hi[3]}, l4 = {lo[0], lo[1], lo[2], lo[3]};
                wh[si][t] = __builtin_bit_cast(bf16x8, h4); wl[si][t] = __builtin_bit_cast(bf16x8, l4); }
        for (int i = F.tid; i < NBUCKET; i += NTHR) lcnt[i] = 0;
        if (F.tid < 4) lbias[F.tid] = p.in[I_BG][layer * 4 + F.tid];
        if (F.tid >= 64 && F.tid < 96) lbias[4 + F.tid - 64] = p.in[I_BE][layer * 32 + F.tid - 64];
        __syncthreads();
    }
    const int rpb = nrows / F.G, r0 = F.bid * rpb;
    f32x4 gm[4], sh[4]; int cur_mr = -1;
    if (MODE == 3) {
#pragma unroll
        for (int q4 = 0; q4 < 4; ++q4) gm[q4] = *(const f32x4*)(gvec + 8 * F.lane + 512 * (q4 >> 1) + 4 * (q4 & 1));
    }
    f32x4 xf[2][4], nf[2][4]; u32x4 xr[2][2], nr[2][2];
#define NORM_LOAD(dstf, dstr, rbase) do { _Pragma("unroll") for (int j = 0; j < 2; ++j) { const int row = r0 + (rbase) + j; \
        if (F32SRC) { const float* xp = (row < T_LAT ? src_lat : src_ctx_adj) + (size_t)row * D; \
            _Pragma("unroll") for (int q4 = 0; q4 < 4; ++q4) dstf[j][q4] = *(const f32x4*)(xp + 8 * F.lane + 512 * (q4 >> 1) + 4 * (q4 & 1)); \
        } else { _Pragma("unroll") for (int q = 0; q < 2; ++q) dstr[j][q] = *(const u32x4*)(X16 + (size_t)row * D + 8 * F.lane + 512 * q); } } } while (0)
    NORM_LOAD(nf, nr, F.wave * 2);
    for (int rr = F.wave * 2; rr < rpb; rr += 16) {
#pragma unroll
        for (int j = 0; j < 2; ++j) {
            if (F32SRC) {
#pragma unroll
                for (int q4 = 0; q4 < 4; ++q4) xf[j][q4] = nf[j][q4];
            } else { xr[j][0] = nr[j][0]; xr[j][1] = nr[j][1]; } }
        if (rr + 16 < rpb) NORM_LOAD(nf, nr, rr + 16);
#pragma unroll
        for (int j = 0; j < 2; ++j) { const int row = r0 + rr + j;
            f32x4 xv[4];
            if (F32SRC) {
#pragma unroll
                for (int q4 = 0; q4 < 4; ++q4) xv[q4] = xf[j][q4];
            } else { pg8::unpack8(xr[j][0], xv[0], xv[1]); pg8::unpack8(xr[j][1], xv[2], xv[3]); }
            float ss = 0.f;
#pragma unroll
            for (int q4 = 0; q4 < 4; ++q4) ss += xv[q4][0] * xv[q4][0] + xv[q4][1] * xv[q4][1] + xv[q4][2] * xv[q4][2] + xv[q4][3] * xv[q4][3];
            ss = wave_allsum(ss);
            const float rstd = rsqrtf(ss * (1.0f / D) + 1e-6f);
            if (MODE == 3) {
#pragma unroll
                for (int q4 = 0; q4 < 4; ++q4) *(f32x4*)(outf + (size_t)row * D + 8 * F.lane + 512 * (q4 >> 1) + 4 * (q4 & 1)) = xv[q4] * rstd * gm[q4];
                continue;
            }
            const int mr = modrow_of(row);
            if (mr != cur_mr) { cur_mr = mr;
#pragma unroll
                for (int q4 = 0; q4 < 4; ++q4) { const int c = 8 * F.lane + 512 * (q4 >> 1) + 4 * (q4 & 1);
                    const f32x4 gq = *(const f32x4*)(gvec + c), sc = *(const f32x4*)(msc + (size_t)mr * MODW + c);
                    gm[q4] = gq * (1.0f + sc); sh[q4] = *(const f32x4*)(msh + (size_t)mr * MODW + c); } }
            f32x4 hv[4];
#pragma unroll
            for (int q4 = 0; q4 < 4; ++q4) hv[q4] = xv[q4] * rstd * gm[q4] + sh[q4];
            if (MODE == 1) { const int chunk = row >> 5, t = row & 31;
#pragma unroll
                for (int q = 0; q < 2; ++q) { const int gi = (F.lane >> 1) + 32 * q, c = 8 * (F.lane & 1);
                    *(u32x4*)(AG + ((size_t)gi * NCHUNK + chunk) * AGLD + t * 16 + c) = pg8::pack8(hv[2 * q], hv[2 * q + 1]); }
            } else {
#pragma unroll
                for (int q = 0; q < 2; ++q) *(u32x4*)(H + (size_t)row * D + 8 * F.lane + 512 * q) = pg8::pack8(hv[2 * q], hv[2 * q + 1]);
            }
            if (MODE == 2) {
                const int br = F.wave * 2 + j;
#pragma unroll
                for (int q = 0; q < 2; ++q) { const int sst = (F.lane >> 2) + 16 * q, slot = (br + 16 * (F.lane & 3)) ^ (sst & 15);
                    const u32x4 hi = pg8::pack8(hv[2 * q], hv[2 * q + 1]); f32x4 h0, h1; pg8::unpack8(hi, h0, h1);
                    const u32x4 lo = pg8::pack8(hv[2 * q] - h0, hv[2 * q + 1] - h1);
                    *(LAS u32x4*)(stage + ((sst * 2 + 0) * 64 + slot) * 16) = hi; *(LAS u32x4*)(stage + ((sst * 2 + 1) * 64 + slot) * 16) = lo; }
            }
        }
        if (MODE == 2) {
            __syncthreads();
            f32x4 acc[3] = {{0.f, 0.f, 0.f, 0.f}, {0.f, 0.f, 0.f, 0.f}, {0.f, 0.f, 0.f, 0.f}};
#pragma unroll
            for (int si = 0; si < 4; ++si) { const int sst = 4 * F.wave + si, slot = F.lane ^ (sst & 15);
                const bf16x8 ah = *(const LAS bf16x8*)(stage + ((sst * 2 + 0) * 64 + slot) * 16), al = *(const LAS bf16x8*)(stage + ((sst * 2 + 1) * 64 + slot) * 16);
#pragma unroll
                for (int t = 0; t < 3; ++t) { acc[t] = __builtin_amdgcn_mfma_f32_16x16x32_bf16(ah, wh[si][t], acc[t], 0, 0, 0);
                    acc[t] = __builtin_amdgcn_mfma_f32_16x16x32_bf16(al, wh[si][t], acc[t], 0, 0, 0); acc[t] = __builtin_amdgcn_mfma_f32_16x16x32_bf16(ah, wl[si][t], acc[t], 0, 0, 0); } }
#pragma unroll
            for (int t = 0; t < 3; ++t)
#pragma unroll
                for (int i = 0; i < 4; ++i) Pp[(F.wave * 16 + 4 * (F.lane >> 4) + i) * 48 + 16 * t + (F.lane & 15)] = acc[t][i];
            __syncthreads();
            for (int e = F.tid; e < 16 * 48; e += NTHR) { float sum = 0.f;
#pragma unroll
                for (int wv = 0; wv < 8; ++wv) sum += Pp[wv * 768 + e];
                Lg[e] = sum; }
            __syncthreads();
#pragma unroll
            for (int j = 0; j < 2; ++j) { const int row = r0 + rr + j; const LAS float* lrow = Lg + (F.wave * 2 + j) * 48;
                float lg[4];
#pragma unroll
                for (int jg = 0; jg < 4; ++jg) lg[jg] = lrow[jg] + lbias[jg];
                int gsel = 0; float gmax = lg[0];
#pragma unroll
                for (int jg = 1; jg < 4; ++jg) if (lg[jg] > gmax) { gmax = lg[jg]; gsel = jg; }
                float gden = 0.f;
#pragma unroll
                for (int jg = 0; jg < 4; ++jg) gden += __expf(lg[jg] - gmax);
                const float gw = 1.0f / gden;
                gsel = __builtin_amdgcn_readfirstlane(gsel);
                float le[8];
#pragma unroll
                for (int e = 0; e < 8; ++e) le[e] = lrow[16 + gsel * 8 + e] + lbias[4 + gsel * 8 + e];
                int i1 = 0; float l1 = le[0];
#pragma unroll
                for (int e = 1; e < 8; ++e) if (le[e] > l1) { l1 = le[e]; i1 = e; }
                int i2 = -1; float l2 = -3.0e38f;
#pragma unroll
                for (int e = 0; e < 8; ++e) if (e != i1 && le[e] > l2) { l2 = le[e]; i2 = e; }
                if (i2 < 0) i2 = (i1 == 0) ? 1 : 0;
                const float r = __expf(l2 - l1), w1 = gw / (1.0f + r), w2 = gw * r / (1.0f + r);
                const int lo = i1 < i2 ? i1 : i2, hi = i1 < i2 ? i2 : i1; const float wlo = i1 < i2 ? w1 : w2, whi = i1 < i2 ? w2 : w1;
                const int bucket = gsel * 28 + lo * 8 - (lo * (lo + 1)) / 2 + (hi - lo - 1);
                if (F.lane == 0) { const int rank = __hip_atomic_fetch_add(lcnt + bucket, 1, __ATOMIC_RELAXED, __HIP_MEMORY_SCOPE_WORKGROUP);
                    i32x4 info; info.x = bucket; info.y = rank; info.z = __float_as_int(wlo); info.w = __float_as_int(whi);
                    *(i32x4*)(p.ws + WS_TOK + (size_t)row * 16) = info; }
            }
        }
    }
#undef NORM_LOAD
    if (MODE == 2) { __syncthreads();
        for (int i = F.tid; i < NBUCKET; i += NTHR) ((int*)(p.ws + WS_CNT))[F.bid * NBUCKET + i] = lcnt[i];
        __syncthreads(); }
}

__device__ __forceinline__ void dispatch_phase(const Frame& F0, const Params& p, int nrows) {
    const Frame F = phase_frame(F0.lds);
    LAS int* tot = (LAS int*)(F.lds);
    LAS int* pre = (LAS int*)(F.lds + 512);
    LAS int* base = (LAS int*)(F.lds + 1024);
    const int* cnt = (const int*)(p.ws + WS_CNT);
    __syncthreads();
    if (F.tid < NBUCKET) { int s = 0, pr = 0;
        for (int b = 0; b < F.G; ++b) { const int v = cnt[b * NBUCKET + F.tid]; pr = (b == F.bid) ? s : pr; s += v; }
        tot[F.tid] = s; pre[F.tid] = pr; }
    __syncthreads();
    if (F.tid == 0) { int o = 0; for (int k = 0; k < NBUCKET; ++k) { base[k] = o; o += (tot[k] + 255) & ~255; } base[NBUCKET] = o; }
    __syncthreads();
    int* perm = (int*)(p.ws + WS_PERM); f32x2* slotw = (f32x2*)(p.ws + WS_SLOTW); int* tile = (int*)(p.ws + WS_TILE);
    if (F.bid == 0) {
        if (F.tid == 0) tile[0] = base[NBUCKET] >> 8;
        for (int k = F.tid; k < NBUCKET; k += NTHR) { const int g = k / 28, pid = k % 28; int lo = 0, rem = pid; while (rem >= 7 - lo) { rem -= 7 - lo; ++lo; } const int hi = lo + 1 + rem;
            const int ee = (g * 8 + lo) | ((g * 8 + hi) << 8);
            for (int mt = base[k] >> 8; mt < (base[k + 1] >> 8); ++mt) tile[16 + mt] = ee; }
    }
    for (int k = F.bid; k < NBUCKET; k += F.G)
        for (int s = base[k] + tot[k] + F.tid; s < base[k + 1]; s += NTHR) { perm[s] = -1; slotw[s] = (f32x2){0.f, 0.f}; }
    const int rpb = nrows / F.G, r0 = F.bid * rpb;
    for (int rr = F.tid; rr < rpb; rr += NTHR) { const int row = r0 + rr;
        const i32x4 info = *(const i32x4*)(p.ws + WS_TOK + (size_t)row * 16);
        const int pos = base[info.x] + pre[info.x] + info.y;
        perm[pos] = row; slotw[pos] = (f32x2){__int_as_float(info.z), __int_as_float(info.w)}; }
    __syncthreads();
}

__device__ __forceinline__ const LAS int* moe_tile_table(const Frame& F0, const Params& p) {
    const Frame F = phase_frame(F0.lds);
    LAS int* lt = (LAS int*)(F.lds + LDS_MISC);
    const int* tile = (const int*)(p.ws + WS_TILE);
    __syncthreads();
    for (int i = F.tid; i < 16 + SLOTS_MAX / 256; i += NTHR) lt[i] = tile[i];
    __syncthreads();
    return lt;
}

template <bool CTX>
__device__ __forceinline__ void conv31_unit(const Frame& F, const bf16_t* Z, bf16_t* A2, int unit, int next_unit, unsigned (&rin)[32], const f32x2 (&w)[31], f32x2 bias, f32x2 lg, f32x2 lb) {
    constexpr int NIN = CTX ? 62 : 32;
    f32x2 xin[NIN]; int tok0, tstride;
    if (CTX) { const int b = unit >> 3, p0 = (unit & 7) * 32; tok0 = T_LAT + b * LCTX + p0; tstride = 1;
#pragma unroll
        for (int j = 0; j < NIN; ++j) { const int pos = p0 - 15 + j; const unsigned v = (pos >= 0 && pos < LCTX) ? *(const unsigned*)(Z + (size_t)(tok0 - 15 + j) * D + 2 * F.tid) : 0u; xin[j] = (f32x2){bf_lo(v), bf_hi(v)}; }
    } else { const int b = unit >> 6, col = unit & 63; tok0 = b * SEQ + col; tstride = 64;
#pragma unroll
        for (int j = 0; j < 32; ++j) xin[j] = (f32x2){bf_lo(rin[j]), bf_hi(rin[j])};
        if (next_unit >= 0) { const int nb = next_unit >> 6, ncol = next_unit & 63, ntok = nb * SEQ + ncol;
#pragma unroll
            for (int j = 0; j < 32; ++j) rin[j] = *(const unsigned*)(Z + (size_t)(ntok + j * 64) * D + 2 * F.tid); }
    }
    f32x2 o[32];
#pragma unroll
    for (int r = 0; r < 32; ++r) { f32x2 s = bias;
#pragma unroll
        for (int k = 0; k < 31; ++k) { const int j = CTX ? r + k : r + k - 15;
            if (j >= 0 && j < NIN) s += w[k] * xin[j]; }
        o[r] = s; }
    float v[64];
#pragma unroll
    for (int r = 0; r < 32; ++r) { v[r] = o[r].x + o[r].y; v[32 + r] = o[r].x * o[r].x + o[r].y * o[r].y; }
#pragma unroll
    for (int st = 32; st >= 1; st >>= 1) { const bool up = (F.lane & st) != 0;
#pragma unroll
        for (int i = 0; i < st; ++i) { const float mine = up ? v[st + i] : v[i], other = up ? v[i] : v[st + i]; v[i] = mine + __shfl_xor(other, st); } }
    LAS float* red = (LAS float*)F.lds;
    LAS float* stat = (LAS float*)(F.lds + 2048);
    __syncthreads();
    red[F.wave * 64 + F.lane] = v[0];
    __syncthreads();
    if (F.tid < 64) { float s = 0.f;
#pragma unroll
        for (int wv = 0; wv < 8; ++wv) s += red[wv * 64 + F.tid];
        stat[F.tid] = s * (1.0f / D); }
    __syncthreads();
#pragma unroll
    for (int r = 0; r < 32; ++r) { const float mu = stat[r], var = stat[32 + r] - mu * mu, rstd = rsqrtf(var + 1e-5f);
        const float y0 = (o[r].x - mu) * rstd * lg.x + lb.x, y1 = (o[r].y - mu) * rstd * lg.y + lb.y;
        *(unsigned*)(A2 + (size_t)(tok0 + r * tstride) * D + 2 * F.tid) = cvt_pk_bf16(y0 * fast_sigmoid(y0), y1 * fast_sigmoid(y1)); }
}
__device__ __forceinline__ void conv31_phase(const Frame& F0, const Params& p, int j, bool with_ctx) {
    const Frame F = phase_frame(F0.lds);
    const bf16_t* Z = (const bf16_t*)(p.ws + WS_T1); bf16_t* A2 = (bf16_t*)(p.ws + WS_T3);
    f32x2 w[31];
#pragma unroll
    for (int k = 0; k < 31; ++k) w[k] = *(const f32x2*)(p.in[I_CDW] + ((size_t)j * 31 + k) * D + 2 * F.tid);
    const f32x2 bias = *(const f32x2*)(p.in[I_CDWB] + (size_t)j * D + 2 * F.tid), lg = *(const f32x2*)(p.in[I_CLNG] + (size_t)j * D + 2 * F.tid), lb = *(const f32x2*)(p.in[I_CLNB] + (size_t)j * D + 2 * F.tid);
    const int nlat = NB * 64, ntot = nlat + (with_ctx ? NB * 8 : 0);
    unsigned rin[32];
    { const int u0 = F.bid, b = u0 >> 6, col = u0 & 63, tok = b * SEQ + col;
#pragma unroll
      for (int jj = 0; jj < 32; ++jj) rin[jj] = *(const unsigned*)(Z + (size_t)(tok + jj * 64) * D + 2 * F.tid); }
    for (int u = F.bid; u < ntot; u += F.G) {
        const int un = u + F.G;
        if (u < nlat) conv31_unit<false>(F, Z, A2, u, un < nlat ? un : -1, rin, w, bias, lg, lb);
        else conv31_unit<true>(F, Z, A2, u - nlat, -1, rin, w, bias, lg, lb);
    }
    __syncthreads();
}

__device__ __forceinline__ void scpre_phase(const Frame& F0, const Params& p) {
    const Frame F = phase_frame(F0.lds);
    const bf16_t* P = (const bf16_t*)(p.ws + WS_T1); const bf16_t* GB = (const bf16_t*)(p.ws + WS_T2); bf16_t* A2 = (bf16_t*)(p.ws + WS_T3);
    const float* cw = p.in[I_SCONV];
    for (int e = F.bid * NTHR + F.tid; e < T_ALL * 128; e += F.G * NTHR) { const int row = e >> 7, ch = (e & 127) * 8;
        bool lv, rv; if (row < T_LAT) { lv = (row & 63) != 0; rv = (row & 63) != 63; } else { const int l = (row - T_LAT) & 255; lv = l != 0; rv = l != 255; }
        const u32x4 z = (u32x4){0u, 0u, 0u, 0u};
        const u32x4 pc = *(const u32x4*)(P + (size_t)row * D + ch), pl = lv ? *(const u32x4*)(P + (size_t)(row - 1) * D + ch) : z, pr = rv ? *(const u32x4*)(P + (size_t)(row + 1) * D + ch) : z;
        const u32x4 gb = *(const u32x4*)(GB + (size_t)row * D + ch);
        float o[8];
#pragma unroll
        for (int q = 0; q < 4; ++q) { const f32x2 w0 = *(const f32x2*)(cw + ch + 2 * q), w1 = *(const f32x2*)(cw + D + ch + 2 * q), w2 = *(const f32x2*)(cw + 2 * D + ch + 2 * q);
            o[2 * q] = bf_lo(gb[q]) * (w0.x * bf_lo(pl[q]) + w1.x * bf_lo(pc[q]) + w2.x * bf_lo(pr[q]));
            o[2 * q + 1] = bf_hi(gb[q]) * (w0.y * bf_hi(pl[q]) + w1.y * bf_hi(pc[q]) + w2.y * bf_hi(pr[q])); }
        u32x4 w; w.x = cvt_pk_bf16(o[0], o[1]); w.y = cvt_pk_bf16(o[2], o[3]); w.z = cvt_pk_bf16(o[4], o[5]); w.w = cvt_pk_bf16(o[6], o[7]);
        *(u32x4*)(A2 + (size_t)row * D + ch) = w; }
}

__device__ __forceinline__ void s5scan_phase(const Frame& F0, const Params& p) {
    const Frame F = phase_frame(F0.lds);
    const float* S = (const float*)(p.ws + WS_T2); bf16_t* AG = (bf16_t*)(p.ws + WS_T1); const f32x2* A32 = (const f32x2*)(p.ws + WS_A32);
    for (int idx = F.bid * NTHR + F.tid; idx < NB * 64 * 2 * 64; idx += F.G * NTHR) {
        const int pp = idx & 63, dir = (idx >> 6) & 1, g = (idx >> 7) & 63, b = idx >> 13;
        const f32x2 a = A32[(g * 2 + dir) * 64 + pp]; float hr = 0.f, hi = 0.f;
        const int col = dir * 128 + 2 * pp;
        for (int st = 0; st < 72; ++st) { int crow;
            if (st < 8) crow = 2048 + b * 8 + (dir ? 7 - st : st); else crow = b * 64 + (dir ? 71 - st : st - 8);
            const size_t ro = (size_t)g * NCHUNK + crow;
            *(unsigned*)(AG + ro * AGLD + 512 + col) = cvt_pk_bf16(hr, hi);
            const f32x2 s = *(const f32x2*)(S + ro * 256 + col);
            const float nr = a.x * hr - a.y * hi + s.x, ni = a.x * hi + a.y * hr + s.y; hr = nr; hi = ni; }
    }
}

__global__ void __launch_bounds__(NTHR, 2) mega(Params p) {
    extern __shared__ __attribute__((aligned(16))) unsigned char lds_raw[];
    Frame F; F.lds = (LAS unsigned char*)lds_raw; F.tid = threadIdx.x; F.lane = F.tid & 63; F.wave = __builtin_amdgcn_readfirstlane(F.tid >> 6); F.G = gridDim.x; F.bid = blockIdx.x;
    unsigned char* ws = p.ws;
#if MK_ONE_LAUNCH
    if (F.tid < 4) ((LAS unsigned*)(F.lds + LDS_BARW))[F.tid] = 0u;
    __syncthreads();
    XcdBarrier bar = xcd_barrier_post((unsigned*)(ws + WS_CTL), (volatile LAS unsigned*)(F.lds + LDS_BARW));
#define GRID_BAR() xcd_barrier(bar)
#else
#define GRID_BAR() do {} while (0)
#endif
    const int lo = p.ph_lo, hi = p.ph_hi;
#ifndef PH_MASK
#define PH_MASK 0xFFFFFFFFu
#endif
#define EN(b) ((PH_MASK >> (b)) & 1u)
#ifndef REP_K2
#define REP_K2 0
#endif
#ifndef REP_MASK
#define REP_MASK 0u
#endif
#define NREP(b) (((REP_MASK >> (b)) & 1u) ? 2 : 1)
#define XSEL(b) ((rep + 1 < NREP(b)) ? X2 : X)
#define IN(k) (lo <= (k) && (k) < hi)
#define SEAM(k) do { if (IN(k) && IN((k) + 1)) GRID_BAR(); } while (0)
    bf16_t* X = (bf16_t*)(ws + WS_X); bf16_t* X2 = (bf16_t*)(ws + WS_END); bf16_t* H = (bf16_t*)(ws + WS_H);
    bf16_t* T1 = (bf16_t*)(ws + WS_T1); bf16_t* T2 = (bf16_t*)(ws + WS_T2); bf16_t* A2 = (bf16_t*)(ws + WS_T3);
    const float* mod = (const float*)(ws + WS_MOD);
    const float* x_in = p.in[I_X]; const float* ctx_adj = p.in[I_CTX] - (size_t)T_LAT * D;

    if (EN(0) && IN(0)) for (int rep = 0; rep < NREP(0); ++rep) { prologue_phase(F, p); } SEAM(0);

#pragma unroll
    for (int layer = 0; layer < DEPTH; ++layer) {
        const int pb = 1 + layer * 10, kind = layer % 3, jj = layer / 3;
        const bool upd = layer < DEPTH - 1; const int M = upd ? T_ALL : T_LAT;
        const float* ml = mod + (size_t)layer * NMOD * MODW;
        const bf16_t* mg16 = (const bf16_t*)(ws + WS_MODG) + (size_t)layer * 2 * NMOD * D;
        if (kind == 0) {
            if (EN(1) && IN(pb + 0)) for (int rep = 0; rep < NREP(1); ++rep) { if (layer == 0) norm_phase<0, true>(F, p, x_in, ctx_adj, X, M, p.in[I_N1G] + layer * D, ml + D, ml, layer, nullptr);
                else norm_phase<0, false>(F, p, x_in, ctx_adj, X, M, p.in[I_N1G] + layer * D, ml + D, ml, layer, nullptr); }
            SEAM(pb + 0);
            if (EN(3) && IN(pb + 1)) for (int rep = 0; rep < NREP(3); ++rep) { pg8::DenseOrder S; S.init(H, ws + WS_WCIN + (size_t)jj * 2048 * 1024 * 2, M, 2048, D, D, 1, 0, 0, F.G, F.bid); S.same = (REP_K2 == 2 && rep + 1 < NREP(3)) ? 1 : 0;
                pg8::EpiGlu E{T1}; pg8::gemm_phase(F.lds, pg8::GemmDesc{D, D, (REP_K2 == 1 && rep + 1 < NREP(3)) ? 2 * D : D, 1 << 20}, S, E); }
            SEAM(pb + 1);
            if (EN(4) && IN(pb + 2)) for (int rep = 0; rep < NREP(4); ++rep) conv31_phase(F, p, jj, upd);
            SEAM(pb + 2);
            if (EN(5) && IN(pb + 3)) for (int rep = 0; rep < NREP(5); ++rep) { pg8::DenseOrder S; S.init(A2, ws + WS_WCOUT + (size_t)jj * 1024 * 1024 * 2, M, 1024, D, D, 1, 0, 0, F.G, F.bid);
                if (layer == 0) { pg8::EpiResid<true> E{x_in, ctx_adj, XSEL(5), mg16}; pg8::gemm_phase(F.lds, pg8::GemmDesc{D, D, D, 1 << 20}, S, E); }
                else { pg8::EpiResid<false> E{x_in, ctx_adj, XSEL(5), mg16}; pg8::gemm_phase(F.lds, pg8::GemmDesc{D, D, D, 1 << 20}, S, E); } }
            SEAM(pb + 3);
        } else if (kind == 1) {
            if (EN(1) && IN(pb + 0)) for (int rep = 0; rep < NREP(1); ++rep) norm_phase<0, false>(F, p, x_in, ctx_adj, X, M, p.in[I_N1G] + layer * D, ml + D, ml, layer, nullptr);
            SEAM(pb + 0);
            if (EN(6) && IN(pb + 1)) for (int rep = 0; rep < NREP(6); ++rep) { pg8::DenseOrder S; S.init(H, ws + WS_WSIN, M, 3072, D, D, 1, 0, 0, F.G, F.bid);
                pg8::EpiSc E{T1, T2}; pg8::gemm_phase(F.lds, pg8::GemmDesc{D, D, D, 1 << 20}, S, E); }
            SEAM(pb + 1);
            if (EN(7) && IN(pb + 2)) for (int rep = 0; rep < NREP(7); ++rep) scpre_phase(F, p);
            SEAM(pb + 2);
            if (EN(8) && IN(pb + 3)) for (int rep = 0; rep < NREP(8); ++rep) { pg8::DenseOrder S; S.init(A2, ws + WS_WSOUT, M, 1024, D, D, 1, 0, 0, F.G, F.bid);
                pg8::EpiResid<false> E{x_in, ctx_adj, XSEL(8), mg16}; pg8::gemm_phase(F.lds, pg8::GemmDesc{D, D, D, 1 << 20}, S, E); }
            SEAM(pb + 3);
        } else {
            if (EN(2) && IN(pb + 0)) for (int rep = 0; rep < NREP(2); ++rep) norm_phase<1, false>(F, p, x_in, ctx_adj, X, M, p.in[I_N1G] + layer * D, ml + D, ml, layer, nullptr);
            SEAM(pb + 0);
            if (EN(9) && IN(pb + 1)) for (int rep = 0; rep < NREP(9); ++rep) { pg8::DenseOrder S; S.init(T1, ws + WS_S5WS, NCHUNK, 256, AGLD, 512, 64, (size_t)NCHUNK * AGLD * 2, (size_t)256 * 512 * 2, F.G, F.bid);
                pg8::EpiS5State E{(float*)T2}; pg8::gemm_phase(F.lds, pg8::GemmDesc{AGLD, 512, 512, 1 << 20}, S, E); }
            SEAM(pb + 1);
            if (EN(10) && IN(pb + 2)) for (int rep = 0; rep < NREP(10); ++rep) s5scan_phase(F, p);
            SEAM(pb + 2);
            if (EN(11) && IN(pb + 3)) for (int rep = 0; rep < NREP(11); ++rep) { pg8::DenseOrder S; S.init(T1, ws + WS_S5WT, NCHUNK, 512, AGLD, AGLD, 64, (size_t)NCHUNK * AGLD * 2, (size_t)512 * AGLD * 2, F.G, F.bid);
                pg8::EpiS5Out E{A2, T1, p.in[I_S5D]}; pg8::gemm_phase(F.lds, pg8::GemmDesc{AGLD, AGLD, AGLD, 1 << 20}, S, E); }
            SEAM(pb + 3);
            if (EN(12) && IN(pb + 4)) for (int rep = 0; rep < NREP(12); ++rep) { pg8::DenseOrder S; S.init(A2, ws + WS_WGLU, M, 2048, D, D, 1, 0, 0, F.G, F.bid);
                pg8::EpiGluResid E{XSEL(12), mg16}; pg8::gemm_phase(F.lds, pg8::GemmDesc{D, D, D, 1 << 20}, S, E); }
            SEAM(pb + 4);
        }
        if (EN(13) && IN(pb + 5)) for (int rep = 0; rep < NREP(13); ++rep) norm_phase<2, false>(F, p, x_in, ctx_adj, X, M, p.in[I_N2G] + layer * D, ml + 4 * D, ml + 3 * D, layer, nullptr);
        SEAM(pb + 5);
        if (EN(14) && IN(pb + 6)) for (int rep = 0; rep < NREP(14); ++rep) dispatch_phase(F, p, M);
        SEAM(pb + 6);
        if (EN(15) && IN(pb + 7)) for (int rep = 0; rep < NREP(15); ++rep) { const LAS int* lt = moe_tile_table(F, p); pg8::MoeOrder<1> S; S.init(H, ws + WS_W13 + (size_t)layer * 32 * 1024 * 1024 * 2, lt, (const int*)(ws + WS_PERM), F.G, F.bid);
            pg8::EpiSwiglu E{T2, (const f32x2*)(ws + WS_SLOTW)}; pg8::gemm_phase(F.lds, pg8::GemmDesc{D, D, D, 1 << 20}, S, E); }
        SEAM(pb + 7);
        if (EN(16) && IN(pb + 8)) for (int rep = 0; rep < NREP(16); ++rep) { const LAS int* lt = moe_tile_table(F, p); pg8::MoeOrder<2> S; S.init(T2, ws + WS_W2 + (size_t)layer * 32 * 1024 * 512 * 2, lt, (const int*)(ws + WS_PERM), F.G, F.bid);
            pg8::EpiMoeDown E{XSEL(16), (const int*)(ws + WS_PERM), mg16 + (size_t)NMOD * D}; pg8::gemm_phase(F.lds, pg8::GemmDesc{D, 512, D, 8}, S, E); }
        SEAM(pb + 8);
    }
    if (EN(17) && IN(41)) norm_phase<3, false>(F, p, x_in, ctx_adj, X, T_LAT, p.in[I_FG], nullptr, nullptr, 0, p.out);
#undef IN
#undef EN
#undef SEAM
}

extern "C" void kernel_launch(void* const* d_in, const int* in_sizes, int n_in, void* d_out, int out_size, void* d_ws, size_t ws_size, hipStream_t stream) {
    static int ready = 0;
    if (ready == 0) {
        if (n_in != 33 || out_size != T_LAT * D || ws_size < WS_END + (REP_MASK ? (size_t)T_ALL * D * 2 : 0)) { fprintf(stderr, "kernel_launch: unexpected shapes (n_in %d out %d ws %zu need %zu)\n", n_in, out_size, ws_size, (size_t)WS_END); ready = -1; return; }
        if (hipFuncSetAttribute((const void*)mega, hipFuncAttributeMaxDynamicSharedMemorySize, LDS_BYTES) != hipSuccess) { fprintf(stderr, "kernel_launch: hipFuncSetAttribute failed\n"); ready = -1; return; }
        int per_cu = 0; (void)hipOccupancyMaxActiveBlocksPerMultiprocessor(&per_cu, (const void*)mega, NTHR, LDS_BYTES); (void)hipGetLastError();
        if (per_cu < 1) fprintf(stderr, "kernel_launch: occupancy query reports %d\n", per_cu);
        ready = 1;
    }
    if (ready < 0) return;
    (void)hipMemsetAsync((char*)d_ws + WS_CTL, 0, CTL_BYTES, stream);
    Params p{};
    for (int i = 0; i < 33; ++i) p.in[i] = (const float*)d_in[i];
    p.out = (float*)d_out; p.ws = (unsigned char*)d_ws;
#if MK_ONE_LAUNCH
    p.ph_lo = 0; p.ph_hi = 42;
    hipLaunchKernelGGL(mega, dim3(NWG), dim3(NTHR), LDS_BYTES, stream, p);
#else
    for (int ph = 0; ph < 42; ++ph) {
        const int l = (ph - 1) / 10, k = (ph - 1) % 10;
        if (ph >= 1 && ph <= 40) { const int kind = l % 3; if (k == 9 || (kind != 2 && k == 4)) continue; }
        p.ph_lo = ph; p.ph_hi = ph + 1;
        hipLaunchKernelGGL(mega, dim3(NWG), dim3(NTHR), LDS_BYTES, stream, p);
    }
#endif
}
```

```cpp
#include <hip/hip_runtime.h>
#include <cstdio>
#include <cstdint>

#ifndef MK_NAIVE
#define MK_NAIVE 0
#endif
#ifndef MK_ALIGN_EPI
#define MK_ALIGN_EPI 1
#endif
#ifndef MK_ONE_LAUNCH
#define MK_ONE_LAUNCH 1
#endif

#define LAS __attribute__((address_space(3)))
typedef unsigned short bf16_t;
typedef short bf16x8 __attribute__((ext_vector_type(8)));
typedef float f32x4 __attribute__((ext_vector_type(4)));
typedef float f32x2 __attribute__((ext_vector_type(2)));
typedef unsigned u32x4 __attribute__((ext_vector_type(4)));
typedef unsigned u32x2 __attribute__((ext_vector_type(2)));
typedef int i32x4 __attribute__((ext_vector_type(4)));

constexpr int D = 1024, NB = 32, SEQ = 2048, LCTX = 256, DEPTH = 4;
constexpr int T_LAT = NB * SEQ, T_CTX = NB * LCTX, T_ALL = T_LAT + T_CTX;
constexpr int NMOD = NB + 1, MODW = 6 * D;
constexpr int NBUCKET = 112, SLOTS_MAX = T_ALL + NBUCKET * 256;
constexpr int NEXP = 32, SLOTSE_MAX = 2 * T_ALL + NEXP * 256;
constexpr int NCHUNK = T_ALL / 32;
constexpr int AGLD = 768;
constexpr int NWG = 256, NTHR = 512;

constexpr size_t al256(size_t x) { return (x + 255) & ~(size_t)255; }
constexpr size_t WS_CTL = 0;
constexpr size_t CTL_BYTES = 65536;
constexpr size_t WS_MOD = WS_CTL + CTL_BYTES;
constexpr size_t WS_MODG = al256(WS_MOD + (size_t)DEPTH * NMOD * MODW * 4);
constexpr size_t WS_A32 = al256(WS_MODG + (size_t)DEPTH * 2 * NMOD * D * 2);
constexpr size_t WS_X = al256(WS_A32 + 64 * 2 * 64 * 8);
constexpr size_t WS_H = al256(WS_X + (size_t)(T_ALL + 1) * D * 2);
constexpr size_t WS_T1 = al256(WS_H + (size_t)T_ALL * D * 2);
constexpr size_t T1_BYTES = (size_t)64 * NCHUNK * AGLD * 2;
constexpr size_t WS_T2 = al256(WS_T1 + T1_BYTES);
constexpr size_t T2_BYTES = (size_t)(SLOTS_MAX + 1) * D * 2;
constexpr size_t WS_T3 = al256(WS_T2 + T2_BYTES);
constexpr size_t WS_TOK = al256(WS_T3 + (size_t)T_ALL * D * 2);
constexpr size_t WS_CNT = al256(WS_TOK + (size_t)T_ALL * 32);
constexpr size_t WS_PERM = al256(WS_CNT + 256 * NBUCKET * 4);
constexpr size_t WS_SLOTW = al256(WS_PERM + (size_t)SLOTS_MAX * 4);
constexpr size_t WS_TILE = al256(WS_SLOTW + (size_t)SLOTS_MAX * 8);
constexpr size_t WS_CNTE = al256(WS_TILE + 8192);
constexpr size_t WS_TOKE = al256(WS_CNTE + 256 * NEXP * 4);
constexpr size_t WS_DSTE = al256(WS_TOKE + (size_t)SLOTSE_MAX * 4);
constexpr size_t WS_WE = al256(WS_DSTE + (size_t)SLOTSE_MAX * 4);
constexpr size_t WS_WCIN = al256(WS_WE + (size_t)SLOTSE_MAX * 4);
constexpr size_t WS_WCOUT = al256(WS_WCIN + (size_t)2 * 2048 * 1024 * 2);
constexpr size_t WS_WSIN = al256(WS_WCOUT + (size_t)2 * 1024 * 1024 * 2);
constexpr size_t WS_WSOUT = al256(WS_WSIN + (size_t)3072 * 1024 * 2);
constexpr size_t WS_WGLU = al256(WS_WSOUT + (size_t)1024 * 1024 * 2);
constexpr size_t WS_W13 = al256(WS_WGLU + (size_t)2048 * 1024 * 2);
constexpr size_t WS_W2 = al256(WS_W13 + (size_t)128 * 1024 * 1024 * 2);
constexpr size_t WS_S5WS = al256(WS_W2 + (size_t)128 * 1024 * 512 * 2);
constexpr size_t WS_S5WT = al256(WS_S5WS + (size_t)64 * 256 * 512 * 2);
constexpr size_t WS_END = al256(WS_S5WT + (size_t)64 * 512 * 768 * 2);
constexpr size_t CTL_QUEUE = 16384;
static_assert(T2_BYTES >= (size_t)64 * NCHUNK * 256 * 4, "aliases");

constexpr int LDS_SCRATCH = 147456;
constexpr int LDS_MISC = LDS_SCRATCH;
constexpr int LDS_BARW = LDS_SCRATCH + 4096;
constexpr int LDS_BYTES = LDS_SCRATCH + 4096 + 64;

__device__ __forceinline__ unsigned cvt_pk_bf16(float lo, float hi) { unsigned r; asm volatile("v_cvt_pk_bf16_f32 %0, %1, %2" : "=v"(r) : "v"(lo), "v"(hi)); return r; }
__device__ __forceinline__ float bf_lo(unsigned u) { return __uint_as_float(u << 16); }
__device__ __forceinline__ float bf_hi(unsigned u) { return __uint_as_float(u & 0xffff0000u); }
__device__ __forceinline__ float fast_sigmoid(float x) { return __builtin_amdgcn_rcpf(1.0f + __expf(-x)); }
__device__ __forceinline__ float wave_allsum(float v) {
    v += __shfl_xor(v, 32); v += __shfl_xor(v, 16); v += __shfl_xor(v, 8); v += __shfl_xor(v, 4); v += __shfl_xor(v, 2); v += __shfl_xor(v, 1); return v; }
__device__ __forceinline__ void wave_sum4(float (&v)[4], int lane) {
    const bool u5 = (lane & 32) != 0, u4 = (lane & 16) != 0;
    float r0 = (u5 ? v[2] : v[0]) + __shfl_xor(u5 ? v[0] : v[2], 32), r1 = (u5 ? v[3] : v[1]) + __shfl_xor(u5 ? v[1] : v[3], 32);
    float s = (u4 ? r1 : r0) + __shfl_xor(u4 ? r0 : r1, 16);
    s += __shfl_xor(s, 8); s += __shfl_xor(s, 4); s += __shfl_xor(s, 2); s += __shfl_xor(s, 1);
#pragma unroll
    for (int i = 0; i < 4; ++i) v[i] = __int_as_float(__builtin_amdgcn_readlane(__float_as_int(s), 16 * i));
}
__device__ __forceinline__ void wave_sum8(float (&v)[8], int lane) {
    const bool u5 = (lane & 32) != 0, u4 = (lane & 16) != 0, u3 = (lane & 8) != 0;
    float a[4];
#pragma unroll
    for (int i = 0; i < 4; ++i) a[i] = (u5 ? v[4 + i] : v[i]) + __shfl_xor(u5 ? v[i] : v[4 + i], 32);
    float b0 = (u4 ? a[2] : a[0]) + __shfl_xor(u4 ? a[0] : a[2], 16), b1 = (u4 ? a[3] : a[1]) + __shfl_xor(u4 ? a[1] : a[3], 16);
    float s = (u3 ? b1 : b0) + __shfl_xor(u3 ? b0 : b1, 8);
    s += __shfl_xor(s, 4); s += __shfl_xor(s, 2); s += __shfl_xor(s, 1);
#pragma unroll
    for (int i = 0; i < 8; ++i) v[i] = __int_as_float(__builtin_amdgcn_readlane(__float_as_int(s), 8 * i));
}
__device__ __forceinline__ int modrow_of(int row) { return row < T_LAT ? (row >> 11) : NB; }

struct Frame { LAS unsigned char* lds; int tid, lane, wave, G, bid; };
__device__ __forceinline__ Frame phase_frame(LAS unsigned char* lds) {
    Frame F; int t = threadIdx.x; asm volatile("" : "+v"(t)); F.lds = lds; F.tid = t; F.lane = t & 63; F.wave = __builtin_amdgcn_readfirstlane(t >> 6); F.G = gridDim.x; F.bid = blockIdx.x; return F; }

#define XB_TMO      128
#define XB_XCNT(j)  (256  + 64 * (j))
#define XB_XSUB(j)  (1280 + 64 * (j))
#define XB_XGEN(j)  (2304 + 64 * (j))
#define XB_TOP      3328
#define XB_TOPGEN   3392
#define XCD_BAR_WORDS 3456
#define XB_SPIN_CAP (1u << 20)
__device__ __forceinline__ unsigned xb_ld(unsigned* p)              { return __hip_atomic_load(p, __ATOMIC_RELAXED, __HIP_MEMORY_SCOPE_AGENT); }
__device__ __forceinline__ unsigned xb_add(unsigned* p, unsigned v) { return __hip_atomic_fetch_add(p, v, __ATOMIC_RELAXED, __HIP_MEMORY_SCOPE_AGENT); }
__device__ __forceinline__ unsigned xb_xcc_id() { return (unsigned)__builtin_amdgcn_s_getreg((3 << 11) | 20) & 0xFu; }
#define XB_SPIN(cond, bar) do { unsigned _sp = 0; while (cond) { __builtin_amdgcn_s_sleep(1); \
    if ((++_sp & 255u) == 0u) { if (xb_ld(&(bar)[XB_TMO])) break; if (_sp > XB_SPIN_CAP) { atomicAdd(&(bar)[XB_TMO], 1u); break; } } } } while (0)
struct XcdBarrier { unsigned* bar; unsigned x; volatile LAS unsigned* st; };
__device__ __forceinline__ XcdBarrier xcd_barrier_post(unsigned* bar, volatile LAS unsigned* st) {
    XcdBarrier b; b.bar = bar; b.x = xb_xcc_id(); b.st = st;
    if (threadIdx.x == 0) (void)xb_add(&bar[XB_XCNT(b.x)], 1u);
    return b;
}
__device__ __forceinline__ void xcd_barrier_complete(unsigned* bar, unsigned x, unsigned& nloc, unsigned& nx) {
    const unsigned G = gridDim.x * gridDim.y * gridDim.z;
    unsigned sum, cnt, mine, sp = 0u;
    for (;;) {
        sum = 0u; cnt = 0u; mine = 0u;
#pragma unroll
        for (unsigned j = 0; j < 16; ++j) { const unsigned c = xb_ld(&bar[XB_XCNT(j)]); sum += c; cnt += (c > 0u) ? 1u : 0u; mine = (j == x) ? c : mine; }
        if (sum == G) break;
        __builtin_amdgcn_s_sleep(1);
        if ((++sp & 255u) == 0u) { if (xb_ld(&bar[XB_TMO])) break; if (sp > XB_SPIN_CAP) { atomicAdd(&bar[XB_TMO], 1u); break; } }
    }
    nloc = mine > 0u ? mine : 1u; nx = cnt > 0u ? cnt : 1u;
}
__device__ __forceinline__ void xcd_barrier(const XcdBarrier& b) {
    asm volatile("s_waitcnt vmcnt(0)" ::: "memory");
    __syncthreads();
    if (threadIdx.x == 0) {
        unsigned* bar = b.bar;
        __builtin_amdgcn_s_waitcnt(0);
        unsigned nloc = b.st[0], nx = b.st[1];
        if (nloc == 0u) { xcd_barrier_complete(bar, b.x, nloc, nx); b.st[0] = nloc; b.st[1] = nx; }
        const unsigned old = xb_add(&bar[XB_XSUB(b.x)], 1u);
        const unsigned gen = old / nloc;
        if (old + 1u == (gen + 1u) * nloc) {
            __builtin_amdgcn_fence(__ATOMIC_RELEASE, "agent");
            asm volatile("s_waitcnt vmcnt(0)" ::: "memory");
            const unsigned og = xb_add(&bar[XB_TOP], 1u);
            const unsigned tg = og / nx;
            if (og + 1u == (tg + 1u) * nx) xb_add(&bar[XB_TOPGEN], 1u);
            else XB_SPIN(xb_ld(&bar[XB_TOPGEN]) == tg, bar);
            __builtin_amdgcn_fence(__ATOMIC_ACQUIRE, "agent");
            xb_add(&bar[XB_XGEN(b.x)], 1u);
            asm volatile("s_waitcnt vmcnt(0)" ::: "memory");
        } else {
            XB_SPIN(xb_ld(&bar[XB_XGEN(b.x)]) == gen, bar);
            __builtin_amdgcn_fence(__ATOMIC_ACQUIRE, "agent");
            asm volatile("s_waitcnt vmcnt(0)" ::: "memory");
        }
    }
    __syncthreads();
}

namespace pg8 {
constexpr int BM = 256, BK = 64, HALF = 128, HTB = HALF * BK * 2, STAGE_BYTES = 8 * HTB, NXCD = 8, WGM = 8;
__host__ __device__ __forceinline__ int lds_byte(int r, int c) { const int st = (r >> 4) * 2 + (c >> 5), rr = r & 15, cc = c & 31, ob = rr * 64 + cc * 2; return st * 1024 + (ob ^ (((ob >> 9) & 1) << 5)); }
__host__ __device__ __forceinline__ void stage_rc(int b, int& R, int& C) { const int st = b / 1024, sb = b % 1024, swz = sb ^ (((sb >> 9) & 1) << 5); R = (st >> 1) * 16 + swz / 64; C = (st & 1) * 32 + (swz % 64) / 2; }
__host__ __device__ __forceinline__ int perm32(int rho) { const int n = rho >> 4, i = rho & 15; return 8 * (i >> 2) + 4 * n + (i & 3); }

struct Unit { int pm, pn, pb; const char* a; const char* b; const char* b1; };
struct GemmDesc { int lda, ldb, K, ksplit; };

#if MK_NAIVE
template <class Epi, class Sched>
__device__ __forceinline__ void gemm_phase(LAS unsigned char* lds, const GemmDesc g, const Sched& S, const Epi& E) {
    int tid_ = threadIdx.x; asm volatile("" : "+v"(tid_));
    const int tid = tid_, wid = tid >> 6, lane = tid & 63, wr = wid >> 2, wc = wid & 3, fr = lane & 15, fq = lane >> 4;
    const int nt = g.K / BK;
    LAS unsigned* As = (LAS unsigned*)lds;
    LAS unsigned* Bs = (LAS unsigned*)(lds + 256 * 33 * 4);
    Unit u;
    for (int ui = 0; S.next(ui, u); ++ui) {
        f32x4 acc[2][2][4][2];
#pragma unroll
        for (int a = 0; a < 2; ++a)
#pragma unroll
            for (int b = 0; b < 2; ++b)
#pragma unroll
                for (int m = 0; m < 4; ++m)
#pragma unroll
                    for (int n = 0; n < 2; ++n) acc[a][b][m][n] = (f32x4){0.f, 0.f, 0.f, 0.f};
#pragma unroll 1
        for (int kt = 0; kt < nt; ++kt) {
            __syncthreads();
            const char* bsrc = (kt < g.ksplit) ? u.b : u.b1;
#pragma unroll
            for (int i = 0; i < 4; ++i) {
                const int piece = tid + i * 512, r = piece >> 3, cq = piece & 7;
                size_t arow = r; if constexpr (Sched::GATHER) arow = S.row_of(u, r);
                const u32x4 va = *(const u32x4*)(u.a + (arow * g.lda) * 2 + (size_t)kt * 128 + cq * 16);
                const u32x4 vb = *(const u32x4*)(bsrc + ((size_t)r * g.ldb) * 2 + (size_t)kt * 128 + cq * 16);
                As[r * 33 + cq * 4 + 0] = va.x; As[r * 33 + cq * 4 + 1] = va.y; As[r * 33 + cq * 4 + 2] = va.z; As[r * 33 + cq * 4 + 3] = va.w;
                Bs[r * 33 + cq * 4 + 0] = vb.x; Bs[r * 33 + cq * 4 + 1] = vb.y; Bs[r * 33 + cq * 4 + 2] = vb.z; Bs[r * 33 + cq * 4 + 3] = vb.w;
            }
            __syncthreads();
#pragma unroll 1
            for (int k2 = 0; k2 < 32; ++k2) {
                float a0[2][4], a1[2][4];
#pragma unroll
                for (int ai = 0; ai < 2; ++ai)
#pragma unroll
                    for (int m = 0; m < 4; ++m) { const unsigned v = As[(ai * 128 + wr * 64 + m * 16 + fr) * 33 + k2]; a0[ai][m] = bf_lo(v); a1[ai][m] = bf_hi(v); }
#pragma unroll
                for (int bj = 0; bj < 2; ++bj)
#pragma unroll
                    for (int n = 0; n < 2; ++n)
#pragma unroll
                        for (int j = 0; j < 4; ++j) {
                            const unsigned v = Bs[(bj * 128 + wc * 32 + fq * 8 + n * 4 + j) * 33 + k2]; const float b0 = bf_lo(v), b1 = bf_hi(v);
#pragma unroll
                            for (int ai = 0; ai < 2; ++ai)
#pragma unroll
                                for (int m = 0; m < 4; ++m) acc[ai][bj][m][n][j] += a0[ai][m] * b0 + a1[ai][m] * b1;
                        }
            }
        }
        E(acc, u, wr, wc, fr, fq);
    }
    __syncthreads();
}
#else
template <class Epi, class Sched>
__device__ __forceinline__ void gemm_phase(LAS unsigned char* lds, const GemmDesc g, const Sched& S, const Epi& E) {
    int tid_ = threadIdx.x; asm volatile("" : "+v"(tid_));
    const int tid = tid_, wid = __builtin_amdgcn_readfirstlane(tid >> 6), lane = tid & 63, wr = wid >> 2, wc = wid & 3, fr = lane & 15, fq = lane >> 4;
    const int nt = g.K / BK, ksplit = g.ksplit;
    unsigned voffB[2]; int Rv[2], Cv[2];
#pragma unroll
    for (int i = 0; i < 2; ++i) { int R, C; stage_rc(tid * 16 + i * 8192, R, C); const int Rb = (R & ~31) + perm32(R & 31);
        Rv[i] = R; Cv[i] = C; voffB[i] = (unsigned)(Rb * g.ldb + C) * 2u; }
    unsigned va[2][2], vn[2][2];
#define PG8_SETV(v, un) do { _Pragma("unroll") for (int _h = 0; _h < 2; ++_h) _Pragma("unroll") for (int _i = 0; _i < 2; ++_i) { \
        if constexpr (Sched::GATHER) (v)[_h][_i] = (unsigned)S.row_of((un), _h * HALF + Rv[_i]) * (unsigned)(g.lda * 2) + (unsigned)(Cv[_i] * 2); \
        else (v)[_h][_i] = (unsigned)((_h * HALF + Rv[_i]) * g.lda + Cv[_i]) * 2u; } } while (0)
    const size_t kstep = (size_t)(BK * 2);
    const size_t hstepB = (size_t)HALF * g.ldb * 2;
    const unsigned ldsw = (unsigned)wid * 1024u;
    const int aoff = lds_byte(wr * 64 + fr, fq * 8), boff = lds_byte(wc * 32 + fr, fq * 8);
#define PG8_SA(b, h) (((b) * 2 + (h)) * HTB)
#define PG8_SB(b, h) ((4 + (b) * 2 + (h)) * HTB)
#define PG8_STAGE(bufoff, gbase, voff) do { _Pragma("unroll") for (int _i = 0; _i < 2; ++_i) \
        __builtin_amdgcn_global_load_lds((const unsigned*)((const char*)(gbase) + (voff)[_i]), (LAS unsigned*)(lds + (bufoff) + ldsw + _i * 8192), 16, 0, 0); } while (0)
#define PG8_STAGEA(bufoff, gbase, h, nx) do { _Pragma("unroll") for (int _i = 0; _i < 2; ++_i) { const unsigned _o = (nx) ? vn[h][_i] : va[h][_i]; \
        __builtin_amdgcn_global_load_lds((const unsigned*)((const char*)(gbase) + _o), (LAS unsigned*)(lds + (bufoff) + ldsw + _i * 8192), 16, 0, 0); } } while (0)
#define PG8_LDA(dst, b, h) do { _Pragma("unroll") for (int m = 0; m < 4; ++m) _Pragma("unroll") for (int k = 0; k < 2; ++k) dst[m][k] = *(const LAS bf16x8*)(lds + PG8_SA(b, h) + aoff + m * 2048 + k * 1024); } while (0)
#define PG8_LDB(dst, b, h) do { _Pragma("unroll") for (int n = 0; n < 2; ++n) _Pragma("unroll") for (int k = 0; k < 2; ++k) dst[n][k] = *(const LAS bf16x8*)(lds + PG8_SB(b, h) + boff + n * 2048 + k * 1024); } while (0)
#define PG8_MMA(ai, bj, At, Bt) do { __builtin_amdgcn_s_setprio(1); _Pragma("unroll") for (int m = 0; m < 4; ++m) _Pragma("unroll") for (int n = 0; n < 2; ++n) _Pragma("unroll") for (int k = 0; k < 2; ++k) \
        acc[ai][bj][m][n] = __builtin_amdgcn_mfma_f32_16x16x32_bf16(Bt[n][k], At[m][k], acc[ai][bj][m][n], 0, 0, 0); __builtin_amdgcn_s_setprio(0); } while (0)
#define PG8_WAIT_V(n) asm volatile("s_waitcnt vmcnt(" #n ")" ::: "memory")
#define PG8_WAIT_L(n) asm volatile("s_waitcnt lgkmcnt(" #n ")" ::: "memory")
#define PG8_BAR __builtin_amdgcn_s_barrier()
#define PG8_SCHED __builtin_amdgcn_sched_barrier(0)
    Unit cur, nxt; int ui = 0;
    if (!S.next(0, cur)) return;
    f32x4 acc[2][2][4][2];
#pragma unroll
    for (int a = 0; a < 2; ++a)
#pragma unroll
        for (int b = 0; b < 2; ++b)
#pragma unroll
            for (int m = 0; m < 4; ++m)
#pragma unroll
                for (int n = 0; n < 2; ++n) acc[a][b][m][n] = (f32x4){0.f, 0.f, 0.f, 0.f};
    bf16x8 At[4][2], B0[2][2], B1[2][2];
    const char* cA = cur.a; const char* cB = cur.b; const char* cB1 = cur.b1;
    PG8_SETV(va, cur);
#pragma unroll
    for (int _h = 0; _h < 2; ++_h)
#pragma unroll
        for (int _i = 0; _i < 2; ++_i) vn[_h][_i] = va[_h][_i];
    PG8_STAGE(PG8_SB(0, 0), cB, voffB); PG8_STAGE(PG8_SB(0, 1), cB + hstepB, voffB); PG8_STAGEA(PG8_SA(0, 0), cA, 0, false); PG8_STAGEA(PG8_SA(0, 1), cA, 1, false);
    if (wr == 1) PG8_BAR;
    PG8_WAIT_V(2); PG8_BAR;
    PG8_STAGE(PG8_SB(1, 0), cB + kstep, voffB); PG8_STAGEA(PG8_SA(1, 0), cA + kstep, 0, false); PG8_STAGE(PG8_SB(1, 1), cB + hstepB + kstep, voffB);
    PG8_WAIT_V(6); PG8_BAR;
    for (;;) {
        const bool has_next = S.next(ui + 1, nxt);
        const char* nA = has_next ? nxt.a : cA; const char* nB = has_next ? nxt.b : cB;
        if (has_next) { PG8_SETV(vn, nxt); }
        for (int t = 0; t < nt; t += 2) {
            const bool last = (t == nt - 2);
            const char* a1 = cA + (size_t)(t + 1) * kstep;
            const char* bsel = (t + 2 < ksplit) ? cB : cB1;
            const char* a2 = last ? nA : cA + (size_t)(t + 2) * kstep; const char* b2 = last ? nB : bsel + (size_t)(t + 2) * kstep;
            const char* a3 = a2 + kstep; const char* b3 = b2 + kstep;
            PG8_LDB(B0, 0, 0); PG8_LDB(B1, 0, 1); PG8_SCHED; PG8_LDA(At, 0, 0); PG8_STAGEA(PG8_SA(1, 1), a1, 1, false);
            PG8_WAIT_V(8); PG8_WAIT_L(0); PG8_BAR; PG8_MMA(0, 0, At, B0); PG8_MMA(0, 1, At, B1); PG8_BAR; PG8_SCHED;
            PG8_LDA(At, 0, 1); PG8_STAGE(PG8_SB(0, 0), b2, voffB); PG8_STAGE(PG8_SB(0, 1), b2 + hstepB, voffB); PG8_STAGEA(PG8_SA(0, 0), a2, 0, last);
            PG8_WAIT_V(8); PG8_WAIT_L(0); PG8_BAR; PG8_MMA(1, 0, At, B0); PG8_MMA(1, 1, At, B1); PG8_BAR; PG8_SCHED;
            PG8_LDB(B0, 1, 0); PG8_LDB(B1, 1, 1); PG8_SCHED; PG8_LDA(At, 1, 0); PG8_STAGEA(PG8_SA(0, 1), a2, 1, last);
            PG8_WAIT_V(8); PG8_WAIT_L(0); PG8_BAR; PG8_MMA(0, 0, At, B0); PG8_MMA(0, 1, At, B1); PG8_BAR; PG8_SCHED;
            PG8_LDA(At, 1, 1); PG8_STAGE(PG8_SB(1, 0), b3, voffB); PG8_STAGE(PG8_SB(1, 1), b3 + hstepB, voffB); PG8_STAGEA(PG8_SA(1, 0), a3, 0, last);
            PG8_WAIT_V(8); PG8_WAIT_L(0); PG8_BAR; PG8_MMA(1, 0, At, B0); PG8_MMA(1, 1, At, B1); PG8_BAR; PG8_SCHED;
        }
#if MK_ALIGN_EPI
        if (wr == 0) PG8_BAR;
#endif
        E(acc, cur, wr, wc, fr, fq);
        if (!has_next) break;
#pragma unroll
        for (int a = 0; a < 2; ++a)
#pragma unroll
            for (int b = 0; b < 2; ++b)
#pragma unroll
                for (int m = 0; m < 4; ++m)
#pragma unroll
                    for (int n = 0; n < 2; ++n) acc[a][b][m][n] = (f32x4){0.f, 0.f, 0.f, 0.f};
        cur = nxt; cA = nA; cB = nB; cB1 = nxt.b1; ++ui;
#pragma unroll
        for (int _h = 0; _h < 2; ++_h)
#pragma unroll
            for (int _i = 0; _i < 2; ++_i) va[_h][_i] = vn[_h][_i];
#if MK_ALIGN_EPI
        if (wr == 1) PG8_BAR;
#endif
    }
    PG8_WAIT_V(0);
#if !MK_ALIGN_EPI
    if (wr == 0) PG8_BAR;
#endif
    PG8_BAR;
#undef PG8_SA
#undef PG8_SB
#undef PG8_STAGE
#undef PG8_STAGEA
#undef PG8_SETV
#undef PG8_LDA
#undef PG8_LDB
#undef PG8_MMA
#undef PG8_WAIT_V
#undef PG8_WAIT_L
#undef PG8_BAR
#undef PG8_SCHED
}
#endif

struct DenseOrder {
    static constexpr bool GATHER = false;
    int same = 0;
    const char* A; const char* Bt; size_t strideA, strideB; int lda, ldb, nM, nN, nB, ntot, G, c;
    __device__ void init(const void* A_, const void* Bt_, int M, int N, int lda_, int ldb_, int nB_, size_t sA, size_t sB, int G_, int c_) {
        A = (const char*)A_; Bt = (const char*)Bt_; lda = lda_; ldb = ldb_; nM = M / BM; nN = N / BM; nB = nB_; ntot = nM * nN * nB; strideA = sA; strideB = sB; G = G_; c = c_; }
    __device__ __forceinline__ bool next(int i, Unit& u) const {
        const int L = i * G + c; if (L >= ntot) return false;
        int wgid = L; { const int q = ntot / NXCD, r = ntot % NXCD, xcd = wgid % NXCD, off = wgid / NXCD; wgid = (xcd < r ? xcd * (q + 1) : r * (q + 1) + (xcd - r) * q) + off; }
        const int per = nM * nN, pb = wgid / per, rem = wgid % per;
        const int nig = WGM * nN, gid = rem / nig, fm = gid * WGM, gsz = (nM - fm) < WGM ? (nM - fm) : WGM;
        u.pm = fm + ((rem % nig) % gsz); u.pn = (rem % nig) / gsz; u.pb = pb;
        u.a = A + (size_t)pb * strideA + (size_t)u.pm * BM * lda * 2; u.b = Bt + (size_t)pb * strideB + (size_t)u.pn * BM * ldb * 2; u.b1 = u.b;
        if (same) { u.a = A; u.b = Bt; u.b1 = Bt; }
        return true;
    }
};
template <int WHICH  > struct MoeOrder {
    static constexpr bool GATHER = (WHICH == 1);
    const char* A; const char* W; const LAS int* tile; const int* perm; int n_mt, nN, ntot, G, c;
    __device__ __forceinline__ int row_of(const Unit& u, int r) const { const int t = perm[u.pm * BM + r]; return t < 0 ? 0 : t; }
    __device__ void init(const void* A_, const void* W_, const LAS int* tile_, const int* perm_, int G_, int c_) {
        A = (const char*)A_; W = (const char*)W_; tile = tile_; perm = perm_; G = G_; c = c_;
        n_mt = __builtin_amdgcn_readfirstlane(tile[0]);
        nN = 4; ntot = n_mt * nN; }
    __device__ __forceinline__ bool next(int i, Unit& u) const {
        const int L = i * G + c; if (L >= ntot) return false;
        int wgid = L; { const int q = ntot / NXCD, r = ntot % NXCD, xcd = wgid % NXCD, off = wgid / NXCD; wgid = (xcd < r ? xcd * (q + 1) : r * (q + 1) + (xcd - r) * q) + off; }
        const int mt = wgid / nN, pn = wgid % nN;
        const int ee = __builtin_amdgcn_readfirstlane(tile[16 + mt]);
        const int elo = ee & 255, ehi = (ee >> 8) & 255;
        u.pm = mt; u.pn = pn; u.pb = 0;
        u.a = (WHICH == 1) ? A : A + (size_t)mt * BM * D * 2;
        if (WHICH == 1) { u.b = W + (size_t)ee * 1024 * 1024 * 2 + (size_t)pn * BM * 1024 * 2; u.b1 = u.b; }
        else { u.b = W + (size_t)elo * 1024 * 512 * 2 + (size_t)pn * BM * 512 * 2; u.b1 = W + (size_t)ehi * 1024 * 512 * 2 + (size_t)pn * BM * 512 * 2 - 8 * 128; }
        return true;
    }
};

#define EPI_ARGS const f32x4 (&acc)[2][2][4][2], const Unit& u, int wr, int wc, int fr, int fq
#define EPI_ROW(ai, m) (u.pm * BM + (ai) * HALF + wr * 64 + (m) * 16 + fr)
__device__ __forceinline__ u32x4 pack8(const f32x4& a, const f32x4& b) { u32x4 w; w.x = cvt_pk_bf16(a[0], a[1]); w.y = cvt_pk_bf16(a[2], a[3]); w.z = cvt_pk_bf16(b[0], b[1]); w.w = cvt_pk_bf16(b[2], b[3]); return w; }

struct EpiGlu { bf16_t* Z;
    __device__ __forceinline__ void operator()(EPI_ARGS) const {
        const int ch = u.pn * 128 + wc * 32 + fq * 8;
#pragma unroll
        for (int ai = 0; ai < 2; ++ai)
#pragma unroll
            for (int m = 0; m < 4; ++m) { f32x4 o[2];
#pragma unroll
                for (int n = 0; n < 2; ++n)
#pragma unroll
                    for (int j = 0; j < 4; ++j) o[n][j] = acc[ai][0][m][n][j] * fast_sigmoid(acc[ai][1][m][n][j]);
                *(u32x4*)(Z + (size_t)EPI_ROW(ai, m) * D + ch) = pack8(o[0], o[1]); }
    }
};
__device__ __forceinline__ void unpack8(const u32x4& v, f32x4& a, f32x4& b) { a[0] = bf_lo(v.x); a[1] = bf_hi(v.x); a[2] = bf_lo(v.y); a[3] = bf_hi(v.y); b[0] = bf_lo(v.z); b[1] = bf_hi(v.z); b[2] = bf_lo(v.w); b[3] = bf_hi(v.w); }
template <bool F32SRC> struct EpiResid { const float* src_lat; const float* src_ctx_adj; bf16_t* X16; const bf16_t* gate16;
    __device__ __forceinline__ void operator()(EPI_ARGS) const {
        const int row0 = u.pm * BM; const float* src = (row0 < T_LAT) ? src_lat : src_ctx_adj; const bf16_t* gp = gate16 + (size_t)modrow_of(row0) * D;
        if (F32SRC) {
#pragma unroll
            for (int bj = 0; bj < 2; ++bj) { const int col = u.pn * BM + bj * HALF + wc * 32 + fq * 8;
                f32x4 g0, g1; unpack8(*(const u32x4*)(gp + col), g0, g1);
#pragma unroll
                for (int ai = 0; ai < 2; ++ai) { f32x4 x0[4], x1[4];
#pragma unroll
                    for (int m = 0; m < 4; ++m) { const size_t o = (size_t)EPI_ROW(ai, m) * D + col; x0[m] = *(const f32x4*)(src + o); x1[m] = *(const f32x4*)(src + o + 4); }
#pragma unroll
                    for (int m = 0; m < 4; ++m) *(u32x4*)(X16 + (size_t)EPI_ROW(ai, m) * D + col) = pack8(x0[m] + g0 * acc[ai][bj][m][0], x1[m] + g1 * acc[ai][bj][m][1]); } }
        } else { u32x4 xs[2][2][4], gg[2];
#pragma unroll
            for (int bj = 0; bj < 2; ++bj) { const int col = u.pn * BM + bj * HALF + wc * 32 + fq * 8; gg[bj] = *(const u32x4*)(gp + col);
#pragma unroll
                for (int ai = 0; ai < 2; ++ai)
#pragma unroll
                    for (int m = 0; m < 4; ++m) xs[bj][ai][m] = *(const u32x4*)(X16 + (size_t)EPI_ROW(ai, m) * D + col); }
#pragma unroll
            for (int bj = 0; bj < 2; ++bj) { const int col = u.pn * BM + bj * HALF + wc * 32 + fq * 8; f32x4 g0, g1; unpack8(gg[bj], g0, g1);
#pragma unroll
                for (int ai = 0; ai < 2; ++ai)
#pragma unroll
                    for (int m = 0; m < 4; ++m) { f32x4 x0, x1; unpack8(xs[bj][ai][m], x0, x1);
                        *(u32x4*)(X16 + (size_t)EPI_ROW(ai, m) * D + col) = pack8(x0 + g0 * acc[ai][bj][m][0], x1 + g1 * acc[ai][bj][m][1]); } } }
    }
};
struct EpiGluResid { bf16_t* X16; const bf16_t* gate16;
    __device__ __forceinline__ void operator()(EPI_ARGS) const {
        const int row0 = u.pm * BM; const int ch = u.pn * 128 + wc * 32 + fq * 8;
        const u32x4 gg = *(const u32x4*)(gate16 + (size_t)modrow_of(row0) * D + ch);
        u32x4 xs[2][4];
#pragma unroll
        for (int ai = 0; ai < 2; ++ai)
#pragma unroll
            for (int m = 0; m < 4; ++m) xs[ai][m] = *(const u32x4*)(X16 + (size_t)EPI_ROW(ai, m) * D + ch);
#pragma unroll
        for (int ai = 0; ai < 2; ++ai)
#pragma unroll
            for (int m = 0; m < 4; ++m) { f32x4 v[2], x0, x1, g0, g1;
                unpack8(xs[ai][m], x0, x1); unpack8(gg, g0, g1);
#pragma unroll
                for (int n = 0; n < 2; ++n)
#pragma unroll
                    for (int j = 0; j < 4; ++j) v[n][j] = acc[ai][0][m][n][j] * fast_sigmoid(acc[ai][1][m][n][j]);
                *(u32x4*)(X16 + (size_t)EPI_ROW(ai, m) * D + ch) = pack8(x0 + g0 * v[0], x1 + g1 * v[1]); }
    }
};
struct EpiSc { bf16_t* P; bf16_t* GB;
    __device__ __forceinline__ void operator()(EPI_ARGS) const {
        if (u.pn < 8) { const int ch = u.pn * 128 + wc * 32 + fq * 8;
#pragma unroll
            for (int ai = 0; ai < 2; ++ai)
#pragma unroll
                for (int m = 0; m < 4; ++m) *(u32x4*)(P + (size_t)EPI_ROW(ai, m) * D + ch) = pack8(acc[ai][0][m][0] * acc[ai][1][m][0], acc[ai][0][m][1] * acc[ai][1][m][1]);
        } else {
#pragma unroll
            for (int bj = 0; bj < 2; ++bj) { const int ch = (u.pn - 8) * BM + bj * HALF + wc * 32 + fq * 8;
#pragma unroll
                for (int ai = 0; ai < 2; ++ai)
#pragma unroll
                    for (int m = 0; m < 4; ++m) *(u32x4*)(GB + (size_t)EPI_ROW(ai, m) * D + ch) = pack8(acc[ai][bj][m][0], acc[ai][bj][m][1]); } }
    }
};
struct EpiSwiglu { bf16_t* ACT; const int* dstE; const float* wE;
    __device__ __forceinline__ void operator()(EPI_ARGS) const {
        const int ch = u.pn * 128 + wc * 32 + fq * 8;
        float wv[2][4]; int dv[2][4];
#pragma unroll
        for (int ai = 0; ai < 2; ++ai)
#pragma unroll
            for (int m = 0; m < 4; ++m) { wv[ai][m] = wE[EPI_ROW(ai, m)]; dv[ai][m] = dstE[EPI_ROW(ai, m)]; }
#pragma unroll
        for (int ai = 0; ai < 2; ++ai)
#pragma unroll
            for (int m = 0; m < 4; ++m) { const float w = wv[ai][m]; f32x4 o[2];
#pragma unroll
                for (int n = 0; n < 2; ++n)
#pragma unroll
                    for (int j = 0; j < 4; ++j) { const float a = acc[ai][0][m][n][j]; o[n][j] = w * a * fast_sigmoid(a) * acc[ai][1][m][n][j]; }
                *(u32x4*)(ACT + (size_t)(dv[ai][m] >> 1) * D + (dv[ai][m] & 1) * 512 + ch) = pack8(o[0], o[1]); }
    }
};
struct EpiMoeDown { bf16_t* X16; const int* perm; const bf16_t* gate16;
    __device__ __forceinline__ void operator()(EPI_ARGS) const {
        int tok[2][4];
#pragma unroll
        for (int ai = 0; ai < 2; ++ai)
#pragma unroll
            for (int m = 0; m < 4; ++m) tok[ai][m] = perm[EPI_ROW(ai, m)];
#pragma unroll
        for (int ai = 0; ai < 2; ++ai)
#pragma unroll
            for (int m = 0; m < 4; ++m) tok[ai][m] = tok[ai][m] < 0 ? T_ALL : tok[ai][m];
#pragma unroll
        for (int bj = 0; bj < 2; ++bj) { const int col = u.pn * BM + bj * HALF + wc * 32 + fq * 8;
#pragma unroll
            for (int ai = 0; ai < 2; ++ai) { u32x4 xs[4], gs[4];
#pragma unroll
                for (int m = 0; m < 4; ++m) { xs[m] = *(const u32x4*)(X16 + (size_t)tok[ai][m] * D + col); gs[m] = *(const u32x4*)(gate16 + (size_t)modrow_of(tok[ai][m]) * D + col); }
#pragma unroll
                for (int m = 0; m < 4; ++m) { f32x4 x0, x1, g0, g1; unpack8(xs[m], x0, x1); unpack8(gs[m], g0, g1);
                    *(u32x4*)(X16 + (size_t)tok[ai][m] * D + col) = pack8(x0 + g0 * acc[ai][bj][m][0], x1 + g1 * acc[ai][bj][m][1]); } } }
    }
};
struct EpiS5State { float* S;
    __device__ __forceinline__ void operator()(EPI_ARGS) const {
#pragma unroll
        for (int bj = 0; bj < 2; ++bj) { const int col = bj * HALF + wc * 32 + fq * 8;
#pragma unroll
            for (int ai = 0; ai < 2; ++ai)
#pragma unroll
                for (int m = 0; m < 4; ++m) { float* o = S + ((size_t)u.pb * NCHUNK + EPI_ROW(ai, m)) * 256 + col;
                    *(f32x4*)o = acc[ai][bj][m][0]; *(f32x4*)(o + 4) = acc[ai][bj][m][1]; } }
    }
};
struct EpiS5Out { bf16_t* YG; const bf16_t* AG; const float* dvec;
    __device__ __forceinline__ void operator()(EPI_ARGS) const {
#pragma unroll
        for (int bj = 0; bj < 2; ++bj) { const int n = u.pn * BM + bj * HALF + wc * 32 + fq * 8, t = n >> 4, ch = u.pb * 16 + (n & 15);
            const f32x4 d0 = *(const f32x4*)(dvec + ch), d1 = *(const f32x4*)(dvec + ch + 4);
            u32x4 us[2][4];
#pragma unroll
            for (int ai = 0; ai < 2; ++ai)
#pragma unroll
                for (int m = 0; m < 4; ++m) us[ai][m] = *(const u32x4*)(AG + ((size_t)u.pb * NCHUNK + EPI_ROW(ai, m)) * AGLD + n);
#pragma unroll
            for (int ai = 0; ai < 2; ++ai)
#pragma unroll
                for (int m = 0; m < 4; ++m) { const int crow = EPI_ROW(ai, m); const u32x4 uu = us[ai][m];
                    f32x4 y0 = acc[ai][bj][m][0], y1 = acc[ai][bj][m][1];
                    y0[0] += d0[0] * bf_lo(uu.x); y0[1] += d0[1] * bf_hi(uu.x); y0[2] += d0[2] * bf_lo(uu.y); y0[3] += d0[3] * bf_hi(uu.y);
                    y1[0] += d1[0] * bf_lo(uu.z); y1[1] += d1[1] * bf_hi(uu.z); y1[2] += d1[2] * bf_lo(uu.w); y1[3] += d1[3] * bf_hi(uu.w);
#pragma unroll
                    for (int j = 0; j < 4; ++j) { const float a = y0[j], b = y1[j];
                        y0[j] = a * fast_sigmoid(1.5957691216f * (a + 0.044715f * a * a * a)); y1[j] = b * fast_sigmoid(1.5957691216f * (b + 0.044715f * b * b * b)); }
                    *(u32x4*)(YG + ((size_t)crow * 32 + t) * D + ch) = pack8(y0, y1); } }
    }
};
}

struct Params { const float* in[33]; float* out; unsigned char* ws; int ph_lo, ph_hi; };
enum { I_X = 0, I_C, I_CTX, I_CCTX, I_ADAW, I_ADAB, I_N1G, I_N2G, I_CWIN, I_CDW, I_CDWB, I_CLNG, I_CLNB, I_CWOUT, I_SWIN, I_SCONV, I_SWOUT,
       I_S5ARE, I_S5AIM, I_S5DT, I_S5BRE, I_S5BIM, I_S5CRE, I_S5CIM, I_S5D, I_S5WGLU, I_WG, I_BG, I_WE, I_BE, I_W13, I_W2, I_FG };

struct ConvJob { const float* src; bf16_t* dst; int K, N, mode, ntile_k, ntile_n, nmat; size_t sstride, dstride; };
__device__ __forceinline__ int conv_dst_row(int mode, int N, int n0) {
    if (mode == 0) return n0;
    if (mode == 1) { const int C = N >> 1, isg = n0 >= C, c = n0 - isg * C; return (c >> 7) * 256 + isg * 128; }
    if (n0 < 1024) return 2048 + n0;
    const int isg = n0 >= 2048, c = n0 - 1024 - isg * 1024; return (c >> 7) * 256 + isg * 128;
}
__device__ void convert_tile(const Frame& F, const ConvJob& J, int t) {
    const int per = J.ntile_k * J.ntile_n, mat = t / per, r = t % per, tk = r / J.ntile_n, tn = r % J.ntile_n;
    const float* src = J.src + (size_t)mat * J.sstride + (size_t)(tk * 64) * J.N + tn * 128;
    LAS unsigned* T = (LAS unsigned*)F.lds;
    __syncthreads();
#pragma unroll
    for (int i = 0; i < 2; ++i) { const int task = F.tid + i * 512, nq = task & 31, kp = task >> 5;
        const f32x4 r0 = *(const f32x4*)(src + (size_t)(2 * kp) * J.N + nq * 4), r1 = *(const f32x4*)(src + (size_t)(2 * kp + 1) * J.N + nq * 4);
#pragma unroll
        for (int j = 0; j < 4; ++j) T[(nq * 4 + j) * 33 + kp] = cvt_pk_bf16(r0[j], r1[j]); }
    __syncthreads();
    bf16_t* dst = J.dst + (size_t)mat * J.dstride + (size_t)conv_dst_row(J.mode, J.N, tn * 128) * J.K + tk * 64;
#pragma unroll
    for (int i = 0; i < 2; ++i) { const int task = F.tid + i * 512, q = task & 7, n = task >> 3;
        u32x4 v; v.x = T[n * 33 + q * 4]; v.y = T[n * 33 + q * 4 + 1]; v.z = T[n * 33 + q * 4 + 2]; v.w = T[n * 33 + q * 4 + 3];
        *(u32x4*)(dst + (size_t)n * J.K + q * 8) = v; }
}
__device__ __forceinline__ ConvJob make_job(const Params& p, int j) {
    ConvJob J; unsigned char* ws = p.ws;
    switch (j) {
    case 0: J = ConvJob{p.in[I_CWIN], (bf16_t*)(ws + WS_WCIN), 1024, 2048, 1, 16, 16, 2, (size_t)1024 * 2048, (size_t)2048 * 1024}; break;
    case 1: J = ConvJob{p.in[I_CWOUT], (bf16_t*)(ws + WS_WCOUT), 1024, 1024, 0, 16, 8, 2, (size_t)1024 * 1024, (size_t)1024 * 1024}; break;
    case 2: J = ConvJob{p.in[I_SWIN], (bf16_t*)(ws + WS_WSIN), 1024, 3072, 2, 16, 24, 1, 0, 0}; break;
    case 3: J = ConvJob{p.in[I_SWOUT], (bf16_t*)(ws + WS_WSOUT), 1024, 1024, 0, 16, 8, 1, 0, 0}; break;
    case 4: J = ConvJob{p.in[I_S5WGLU], (bf16_t*)(ws + WS_WGLU), 1024, 2048, 1, 16, 16, 1, 0, 0}; break;
    case 5: J = ConvJob{p.in[I_W13], (bf16_t*)(ws + WS_W13), 1024, 1024, 1, 16, 8, 128, (size_t)1024 * 1024, (size_t)1024 * 1024}; break;
    default: J = ConvJob{p.in[I_W2], (bf16_t*)(ws + WS_W2), 512, 1024, 0, 8, 8, 128, (size_t)512 * 1024, (size_t)1024 * 512}; break;
    }
    return J;
}
__device__ void mod_task(const Frame& F, const Params& p, int t) {
    const int layer = t / 96, n0 = (t % 96) * 64;
    const float* W = p.in[I_ADAW] + (size_t)layer * D * MODW; const float* bias = p.in[I_ADAB] + (size_t)layer * MODW;
    float* mod = (float*)(p.ws + WS_MOD) + (size_t)layer * NMOD * MODW;
    LAS float* sc = (LAS float*)F.lds;
    LAS float* red = (LAS float*)(F.lds + 33 * 512 * 4);
    float acc[NMOD];
#pragma unroll
    for (int r = 0; r < NMOD; ++r) acc[r] = 0.f;
    for (int half = 0; half < 2; ++half) {
        __syncthreads();
        for (int i = F.tid; i < NMOD * 512; i += NTHR) { const int r = i >> 9, k = (i & 511) + half * 512;
            const float v = (r < NB) ? p.in[I_C][r * D + k] : p.in[I_CCTX][k]; sc[i] = v * fast_sigmoid(v); }
        __syncthreads();
#pragma unroll 8
        for (int kk = 0; kk < 64; ++kk) { const int kl = F.wave * 64 + kk; const float w = W[(size_t)(half * 512 + kl) * MODW + n0 + F.lane];
#pragma unroll
            for (int r = 0; r < NMOD; ++r) acc[r] += sc[r * 512 + kl] * w; }
    }
#pragma unroll
    for (int r = 0; r < NMOD; ++r) red[(F.wave * NMOD + r) * 64 + F.lane] = acc[r];
    __syncthreads();
    for (int i = F.tid; i < NMOD * 64; i += NTHR) { const int r = i >> 6, l = i & 63; float s = bias[n0 + l];
#pragma unroll
        for (int w = 0; w < 8; ++w) s += red[(w * NMOD + r) * 64 + l];
        mod[(size_t)r * MODW + n0 + l] = s;
        const int chunk = n0 >> 10;
        if (chunk == 2 || chunk == 5) ((bf16_t*)(p.ws + WS_MODG))[((size_t)(layer * 2 + (chunk == 5)) * NMOD + r) * D + (n0 & 1023) + l] = (bf16_t)(cvt_pk_bf16(s, 0.f) & 0xffffu); }
    __syncthreads();
}
__device__ void s5_build(const Frame& F, const Params& p, int g) {
    LAS f32x2* P = (LAS f32x2*)F.lds;
    LAS f32x2* Bb = (LAS f32x2*)(F.lds + 33792);
    LAS f32x2* Cc = (LAS f32x2*)(F.lds + 33792 + 16384);
    LAS float* Kd = (LAS float*)(F.lds + 33792 + 32768);
    __syncthreads();
    if (F.tid < 128) { const int dir = F.tid >> 6, pp = F.tid & 63, gi = (dir * 64 + g) * 64 + pp;
        double are = (double)p.in[I_S5ARE][gi]; if (are > -1e-4) are = -1e-4; const double aim = (double)p.in[I_S5AIM][gi];
        const double dt = exp((double)p.in[I_S5DT][dir * 64 + g]);
        double ab_re = 0, ab_im = 0;
        for (int n = 0; n <= 32; ++n) { const double mag = exp(n * dt * are), ang = n * dt * aim, cr = mag * cos(ang), ci = mag * sin(ang);
            P[(dir * 64 + pp) * 33 + n] = (f32x2){(float)cr, (float)ci}; if (n == 1) { ab_re = cr; ab_im = ci; }
            if (n == 32) ((f32x2*)(p.ws + WS_A32))[(g * 2 + dir) * 64 + pp] = (f32x2){(float)cr, (float)ci}; }
        const double den = are * are + aim * aim, nre = ab_re - 1.0, nim = ab_im;
        const double kre = (nre * are + nim * aim) / den, kim = (nim * are - nre * aim) / den;
        for (int c = 0; c < 16; ++c) { const double br = (double)p.in[I_S5BRE][(size_t)gi * 16 + c], bi = (double)p.in[I_S5BIM][(size_t)gi * 16 + c];
            Bb[(dir * 64 + pp) * 16 + c] = (f32x2){(float)(kre * br - kim * bi), (float)(kre * bi + kim * br)}; }
        for (int c = 0; c < 16; ++c) { const size_t ci = ((size_t)(dir * 64 + g) * 16 + c) * 64 + pp;
            Cc[(dir * 16 + c) * 64 + pp] = (f32x2){p.in[I_S5CRE][ci], p.in[I_S5CIM][ci]}; }
    }
    __syncthreads();
    for (int e = F.tid; e < 2 * 32 * 256; e += NTHR) { const int dir = e >> 13, d = (e >> 8) & 31, c = (e >> 4) & 15, c2 = e & 15; float s = 0.f;
#pragma unroll 2
        for (int pp = 0; pp < 64; ++pp) { const f32x2 C = Cc[(dir * 16 + c) * 64 + pp], E = P[(dir * 64 + pp) * 33 + d], B = Bb[(dir * 64 + pp) * 16 + c2];
            const float er = E.x * B.x - E.y * B.y, ei = E.x * B.y + E.y * B.x; s += C.x * er - C.y * ei; }
        Kd[e] = s; }
    __syncthreads();
    unsigned* WT = (unsigned*)(p.ws + WS_S5WT) + (size_t)g * 512 * 384;
    for (int e = F.tid; e < 512 * 384; e += NTHR) { const int n = e / 384, k0 = (e % 384) * 2, t = n >> 4, c = n & 15; float v[2];
#pragma unroll
        for (int h = 0; h < 2; ++h) { const int k = k0 + h;
            if (k < 512) { const int s = k >> 4, c2 = k & 15;
                v[h] = (s < t) ? Kd[((0 * 32 + (t - s)) * 16 + c) * 16 + c2] : (s > t) ? Kd[((1 * 32 + (s - t)) * 16 + c) * 16 + c2] : (Kd[(c) * 16 + c2] + Kd[((32) * 16 + c) * 16 + c2]);
            } else { const int kk = k - 512, dir = kk >> 7, pp = (kk >> 1) & 63, ri = kk & 1;
                const f32x2 E = P[(dir * 64 + pp) * 33 + (dir == 0 ? t + 1 : 32 - t)], C = Cc[(dir * 16 + c) * 64 + pp];
                const float cr = C.x * E.x - C.y * E.y, ci = C.x * E.y + C.y * E.x; v[h] = ri ? -ci : cr; } }
        WT[e] = cvt_pk_bf16(v[0], v[1]); }
    unsigned* WSm = (unsigned*)(p.ws + WS_S5WS) + (size_t)g * 256 * 256;
    for (int e = F.tid; e < 256 * 256; e += NTHR) { const int n = e >> 8, k0 = (e & 255) * 2, dir = n >> 7, pp = (n >> 1) & 63, ri = n & 1; float v[2];
#pragma unroll
        for (int h = 0; h < 2; ++h) { const int k = k0 + h, s = k >> 4, c = k & 15;
            const f32x2 E = P[(dir * 64 + pp) * 33 + (dir == 0 ? 31 - s : s)], B = Bb[(dir * 64 + pp) * 16 + c];
            v[h] = ri ? (E.x * B.y + E.y * B.x) : (E.x * B.x - E.y * B.y); }
        WSm[e] = cvt_pk_bf16(v[0], v[1]); }
    __syncthreads();
}
__device__ __forceinline__ void prologue_phase(const Frame& F0, const Params& p) {
    const Frame F = phase_frame(F0.lds);
    if (F.bid < 64) s5_build(F, p, F.bid);
    else for (int t = F.bid - 64; t < 4 * 96; t += F.G - 64) mod_task(F, p, t);
    unsigned* qhead = (unsigned*)(p.ws + WS_CTL + CTL_QUEUE);
    LAS int* bc = (LAS int*)(F.lds + LDS_MISC);
    int jbase[8]; jbase[0] = 0;
#pragma unroll
    for (int j = 0; j < 7; ++j) { const ConvJob J = make_job(p, j); jbase[j + 1] = jbase[j] + J.ntile_k * J.ntile_n * J.nmat; }
    for (;;) {
        __syncthreads();
        if (F.tid == 0) bc[0] = (int)__hip_atomic_fetch_add(qhead, 1u, __ATOMIC_RELAXED, __HIP_MEMORY_SCOPE_AGENT);
        __syncthreads();
        const int t0 = bc[0] * 4;
        if (t0 >= jbase[7]) break;
        int j = 0;
#pragma unroll
        for (int k = 1; k < 7; ++k) if (t0 >= jbase[k]) j = k;
        const ConvJob J = make_job(p, j);
        int jb = 0;
#pragma unroll
        for (int k = 0; k < 7; ++k) if (k == j) jb = jbase[k];
        for (int t = t0; t < t0 + 4; ++t) convert_tile(F, J, t - jb);
    }
    __syncthreads();
}

template <int MODE, bool F32SRC>
__device__ __forceinline__ void norm_phase(const Frame& F0, const Params& p, const float* src_lat, const float* src_ctx_adj, const bf16_t* X16, int nrows, const float* gvec, const float* msc, const float* msh,
                           int layer, float* outf) {
    const Frame F = phase_frame(F0.lds);
    bf16_t* H = (bf16_t*)(p.ws + WS_H); bf16_t* AG = (bf16_t*)(p.ws + WS_T1);
    LAS int* lcnt = (LAS int*)(F.lds + LDS_MISC);
    LAS float* lbias = (LAS float*)(F.lds + LDS_MISC + 512);
    LAS int* lcntE = (LAS int*)(F.lds + LDS_MISC + 768);
    bf16x8 wh[4][3], wl[4][3];
    LAS unsigned char* stage = F.lds;
    LAS float* Pp = (LAS float*)(F.lds + 65536);
    LAS float* Lg = (LAS float*)(F.lds + 65536 + 24576);
    if (MODE == 2) {
        __syncthreads();
        const float* wg = p.in[I_WG] + (size_t)layer * D * 4; const float* we = p.in[I_WE] + (size_t)layer * D * 32;
        const int c = F.lane & 15, kq = F.lane >> 4;
#pragma unroll
        for (int si = 0; si < 4; ++si)
#pragma unroll
            for (int t = 0; t < 3; ++t) { float v[8];
#pragma unroll
                for (int j = 0; j < 8; ++j) { const int k = 32 * (4 * F.wave + si) + 8 * kq + j;
                    v[j] = (t == 0) ? (c < 4 ? wg[k * 4 + c] : 0.f) : we[k * 32 + (t - 1) * 16 + c]; }
                unsigned hi[4], lo[4];
#pragma unroll
                for (int j = 0; j < 4; ++j) { hi[j] = cvt_pk_bf16(v[2 * j], v[2 * j + 1]); lo[j] = cvt_pk_bf16(v[2 * j] - bf_lo(hi[j]), v[2 * j + 1] - bf_hi(hi[j])); }
                u32x4 h4 = {hi[0], hi[1], hi[2], hi[3]}, l4 = {lo[0], lo[1], lo[2], lo[3]};
                wh[si][t] = __builtin_bit_cast(bf16x8, h4); wl[si][t] = __builtin_bit_cast(bf16x8, l4); }
        for (int i = F.tid; i < NBUCKET; i += NTHR) lcnt[i] = 0;
        if (F.tid >= 128 && F.tid < 128 + NEXP) lcntE[F.tid - 128] = 0;
        if (F.tid < 4) lbias[F.tid] = p.in[I_BG][layer * 4 + F.tid];
        if (F.tid >= 64 && F.tid < 96) lbias[4 + F.tid - 64] = p.in[I_BE][layer * 32 + F.tid - 64];
        __syncthreads();
    }
    const int rpb = nrows / F.G, r0 = F.bid * rpb;
    f32x4 gm[4], sh[4]; int cur_mr = -1;
    if (MODE == 3) {
#pragma unroll
        for (int q4 = 0; q4 < 4; ++q4) gm[q4] = *(const f32x4*)(gvec + 8 * F.lane + 512 * (q4 >> 1) + 4 * (q4 & 1));
    }
    f32x4 xf[2][4], nf[2][4]; u32x4 xr[2][2], nr[2][2];
#define NORM_LOAD(dstf, dstr, rbase) do { _Pragma("unroll") for (int j = 0; j < 2; ++j) { const int row = r0 + (rbase) + j; \
        if (F32SRC) { const float* xp = (row < T_LAT ? src_lat : src_ctx_adj) + (size_t)row * D; \
            _Pragma("unroll") for (int q4 = 0; q4 < 4; ++q4) dstf[j][q4] = *(const f32x4*)(xp + 8 * F.lane + 512 * (q4 >> 1) + 4 * (q4 & 1)); \
        } else { _Pragma("unroll") for (int q = 0; q < 2; ++q) dstr[j][q] = *(const u32x4*)(X16 + (size_t)row * D + 8 * F.lane + 512 * q); } } } while (0)
    NORM_LOAD(nf, nr, F.wave * 2);
    for (int rr = F.wave * 2; rr < rpb; rr += 16) {
#pragma unroll
        for (int j = 0; j < 2; ++j) {
            if (F32SRC) {
#pragma unroll
                for (int q4 = 0; q4 < 4; ++q4) xf[j][q4] = nf[j][q4];
            } else { xr[j][0] = nr[j][0]; xr[j][1] = nr[j][1]; } }
        if (rr + 16 < rpb) NORM_LOAD(nf, nr, rr + 16);
#pragma unroll
        for (int j = 0; j < 2; ++j) { const int row = r0 + rr + j;
            f32x4 xv[4];
            if (F32SRC) {
#pragma unroll
                for (int q4 = 0; q4 < 4; ++q4) xv[q4] = xf[j][q4];
            } else { pg8::unpack8(xr[j][0], xv[0], xv[1]); pg8::unpack8(xr[j][1], xv[2], xv[3]); }
            float ss = 0.f;
#pragma unroll
            for (int q4 = 0; q4 < 4; ++q4) ss += xv[q4][0] * xv[q4][0] + xv[q4][1] * xv[q4][1] + xv[q4][2] * xv[q4][2] + xv[q4][3] * xv[q4][3];
            ss = wave_allsum(ss);
            const float rstd = rsqrtf(ss * (1.0f / D) + 1e-6f);
            if (MODE == 3) {
#pragma unroll
                for (int q4 = 0; q4 < 4; ++q4) *(f32x4*)(outf + (size_t)row * D + 8 * F.lane + 512 * (q4 >> 1) + 4 * (q4 & 1)) = xv[q4] * rstd * gm[q4];
                continue;
            }
            const int mr = modrow_of(row);
            if (mr != cur_mr) { cur_mr = mr;
#pragma unroll
                for (int q4 = 0; q4 < 4; ++q4) { const int c = 8 * F.lane + 512 * (q4 >> 1) + 4 * (q4 & 1);
                    const f32x4 gq = *(const f32x4*)(gvec + c), sc = *(const f32x4*)(msc + (size_t)mr * MODW + c);
                    gm[q4] = gq * (1.0f + sc); sh[q4] = *(const f32x4*)(msh + (size_t)mr * MODW + c); } }
            f32x4 hv[4];
#pragma unroll
            for (int q4 = 0; q4 < 4; ++q4) hv[q4] = xv[q4] * rstd * gm[q4] + sh[q4];
            if (MODE == 1) { const int chunk = row >> 5, t = row & 31;
#pragma unroll
                for (int q = 0; q < 2; ++q) { const int gi = (F.lane >> 1) + 32 * q, c = 8 * (F.lane & 1);
                    *(u32x4*)(AG + ((size_t)gi * NCHUNK + chunk) * AGLD + t * 16 + c) = pg8::pack8(hv[2 * q], hv[2 * q + 1]); }
            } else {
#pragma unroll
                for (int q = 0; q < 2; ++q) *(u32x4*)(H + (size_t)row * D + 8 * F.lane + 512 * q) = pg8::pack8(hv[2 * q], hv[2 * q + 1]);
            }
            if (MODE == 2) {
                const int br = F.wave * 2 + j;
#pragma unroll
                for (int q = 0; q < 2; ++q) { const int sst = (F.lane >> 2) + 16 * q, slot = (br + 16 * (F.lane & 3)) ^ (sst & 15);
                    const u32x4 hi = pg8::pack8(hv[2 * q], hv[2 * q + 1]); f32x4 h0, h1; pg8::unpack8(hi, h0, h1);
                    const u32x4 lo = pg8::pack8(hv[2 * q] - h0, hv[2 * q + 1] - h1);
                    *(LAS u32x4*)(stage + ((sst * 2 + 0) * 64 + slot) * 16) = hi; *(LAS u32x4*)(stage + ((sst * 2 + 1) * 64 + slot) * 16) = lo; }
            }
        }
        if (MODE == 2) {
            __syncthreads();
            f32x4 acc[3] = {{0.f, 0.f, 0.f, 0.f}, {0.f, 0.f, 0.f, 0.f}, {0.f, 0.f, 0.f, 0.f}};
#pragma unroll
            for (int si = 0; si < 4; ++si) { const int sst = 4 * F.wave + si, slot = F.lane ^ (sst & 15);
                const bf16x8 ah = *(const LAS bf16x8*)(stage + ((sst * 2 + 0) * 64 + slot) * 16), al = *(const LAS bf16x8*)(stage + ((sst * 2 + 1) * 64 + slot) * 16);
#pragma unroll
                for (int t = 0; t < 3; ++t) { acc[t] = __builtin_amdgcn_mfma_f32_16x16x32_bf16(ah, wh[si][t], acc[t], 0, 0, 0);
                    acc[t] = __builtin_amdgcn_mfma_f32_16x16x32_bf16(al, wh[si][t], acc[t], 0, 0, 0); acc[t] = __builtin_amdgcn_mfma_f32_16x16x32_bf16(ah, wl[si][t], acc[t], 0, 0, 0); } }
#pragma unroll
            for (int t = 0; t < 3; ++t)
#pragma unroll
                for (int i = 0; i < 4; ++i) Pp[(F.wave * 16 + 4 * (F.lane >> 4) + i) * 48 + 16 * t + (F.lane & 15)] = acc[t][i];
            __syncthreads();
            for (int e = F.tid; e < 16 * 48; e += NTHR) { float sum = 0.f;
#pragma unroll
                for (int wv = 0; wv < 8; ++wv) sum += Pp[wv * 768 + e];
                Lg[e] = sum; }
            __syncthreads();
#pragma unroll
            for (int j = 0; j < 2; ++j) { const int row = r0 + rr + j; const LAS float* lrow = Lg + (F.wave * 2 + j) * 48;
                float lg[4];
#pragma unroll
                for (int jg = 0; jg < 4; ++jg) lg[jg] = lrow[jg] + lbias[jg];
                int gsel = 0; float gmax = lg[0];
#pragma unroll
                for (int jg = 1; jg < 4; ++jg) if (lg[jg] > gmax) { gmax = lg[jg]; gsel = jg; }
                float gden = 0.f;
#pragma unroll
                for (int jg = 0; jg < 4; ++jg) gden += __expf(lg[jg] - gmax);
                const float gw = 1.0f / gden;
                gsel = __builtin_amdgcn_readfirstlane(gsel);
                float le[8];
#pragma unroll
                for (int e = 0; e < 8; ++e) le[e] = lrow[16 + gsel * 8 + e] + lbias[4 + gsel * 8 + e];
                int i1 = 0; float l1 = le[0];
#pragma unroll
                for (int e = 1; e < 8; ++e) if (le[e] > l1) { l1 = le[e]; i1 = e; }
                int i2 = -1; float l2 = -3.0e38f;
#pragma unroll
                for (int e = 0; e < 8; ++e) if (e != i1 && le[e] > l2) { l2 = le[e]; i2 = e; }
                if (i2 < 0) i2 = (i1 == 0) ? 1 : 0;
                const float r = __expf(l2 - l1), w1 = gw / (1.0f + r), w2 = gw * r / (1.0f + r);
                const int lo = i1 < i2 ? i1 : i2, hi = i1 < i2 ? i2 : i1; const float wlo = i1 < i2 ? w1 : w2, whi = i1 < i2 ? w2 : w1;
                const int bucket = gsel * 28 + lo * 8 - (lo * (lo + 1)) / 2 + (hi - lo - 1);
                if (F.lane == 0) { const int rank = __hip_atomic_fetch_add(lcnt + bucket, 1, __ATOMIC_RELAXED, __HIP_MEMORY_SCOPE_WORKGROUP);
                    const int elo = gsel * 8 + lo, ehi = gsel * 8 + hi;
                    const int rlo = __hip_atomic_fetch_add(lcntE + elo, 1, __ATOMIC_RELAXED, __HIP_MEMORY_SCOPE_WORKGROUP), rhi = __hip_atomic_fetch_add(lcntE + ehi, 1, __ATOMIC_RELAXED, __HIP_MEMORY_SCOPE_WORKGROUP);
                    i32x4 info; info.x = bucket; info.y = rank; info.z = __float_as_int(wlo); info.w = __float_as_int(whi);
                    i32x4 inf2; inf2.x = elo; inf2.y = ehi; inf2.z = rlo; inf2.w = rhi;
                    *(i32x4*)(p.ws + WS_TOK + (size_t)row * 32) = info; *(i32x4*)(p.ws + WS_TOK + (size_t)row * 32 + 16) = inf2; }
            }
        }
    }
#undef NORM_LOAD
    if (MODE == 2) { __syncthreads();
        for (int i = F.tid; i < NBUCKET; i += NTHR) ((int*)(p.ws + WS_CNT))[F.bid * NBUCKET + i] = lcnt[i];
        if (F.tid >= 128 && F.tid < 128 + NEXP) ((int*)(p.ws + WS_CNTE))[F.bid * NEXP + F.tid - 128] = lcntE[F.tid - 128];
        __syncthreads(); }
}

__device__ __forceinline__ void dispatch_phase(const Frame& F0, const Params& p, int nrows) {
    const Frame F = phase_frame(F0.lds);
    LAS int* tot = (LAS int*)(F.lds);
    LAS int* pre = (LAS int*)(F.lds + 512);
    LAS int* base = (LAS int*)(F.lds + 1024);
    LAS int* totE = (LAS int*)(F.lds + 1536);
    LAS int* preE = (LAS int*)(F.lds + 1792);
    LAS int* baseE = (LAS int*)(F.lds + 2048);
    const int* cnt = (const int*)(p.ws + WS_CNT); const int* cntE = (const int*)(p.ws + WS_CNTE);
    __syncthreads();
    if (F.tid < NBUCKET) { int s = 0, pr = 0;
        for (int b = 0; b < F.G; ++b) { const int v = cnt[b * NBUCKET + F.tid]; pr = (b == F.bid) ? s : pr; s += v; }
        tot[F.tid] = s; pre[F.tid] = pr; }
    if (F.tid >= 128 && F.tid < 128 + NEXP) { const int e = F.tid - 128; int s = 0, pr = 0;
        for (int b = 0; b < F.G; ++b) { const int v = cntE[b * NEXP + e]; pr = (b == F.bid) ? s : pr; s += v; }
        totE[e] = s; preE[e] = pr; }
    __syncthreads();
    if (F.tid == 0) { int o = 0; for (int k = 0; k < NBUCKET; ++k) { base[k] = o; o += (tot[k] + 255) & ~255; } base[NBUCKET] = o; }
    if (F.tid == 64) { int o = 0; for (int e = 0; e < NEXP; ++e) { baseE[e] = o; o += (totE[e] + 255) & ~255; } baseE[NEXP] = o; }
    __syncthreads();
    int* perm = (int*)(p.ws + WS_PERM); int* tile = (int*)(p.ws + WS_TILE); int* tileE = (int*)(p.ws + WS_TILE + 4096);
    int* tokE = (int*)(p.ws + WS_TOKE); int* dstE = (int*)(p.ws + WS_DSTE); float* wE = (float*)(p.ws + WS_WE);
    if (F.bid == 0) {
        if (F.tid == 0) { tile[0] = base[NBUCKET] >> 8; tileE[0] = baseE[NEXP] >> 8; }
        for (int k = F.tid; k < NBUCKET; k += NTHR) { const int g = k / 28, pid = k % 28; int lo = 0, rem = pid; while (rem >= 7 - lo) { rem -= 7 - lo; ++lo; } const int hi = lo + 1 + rem;
            const int ee = (g * 8 + lo) | ((g * 8 + hi) << 8);
            for (int mt = base[k] >> 8; mt < (base[k + 1] >> 8); ++mt) tile[16 + mt] = ee; }
        if (F.tid >= 128 && F.tid < 128 + NEXP) { const int e = F.tid - 128; for (int mt = baseE[e] >> 8; mt < (baseE[e + 1] >> 8); ++mt) tileE[16 + mt] = e; }
    }
    for (int k = F.bid; k < NBUCKET; k += F.G)
        for (int sl = base[k] + tot[k] + F.tid; sl < base[k + 1]; sl += NTHR) perm[sl] = -1;
    for (int e = F.bid; e < NEXP; e += F.G)
        for (int sl = baseE[e] + totE[e] + F.tid; sl < baseE[e + 1]; sl += NTHR) { tokE[sl] = -1; dstE[sl] = 2 * SLOTS_MAX; wE[sl] = 0.f; }
    const int rpb = nrows / F.G, r0 = F.bid * rpb;
    for (int rr = F.tid; rr < rpb; rr += NTHR) { const int row = r0 + rr;
        const i32x4 info = *(const i32x4*)(p.ws + WS_TOK + (size_t)row * 32), inf2 = *(const i32x4*)(p.ws + WS_TOK + (size_t)row * 32 + 16);
        const int pos = base[info.x] + pre[info.x] + info.y;
        perm[pos] = row;
        const int slo = baseE[inf2.x] + preE[inf2.x] + inf2.z, shi = baseE[inf2.y] + preE[inf2.y] + inf2.w;
        tokE[slo] = row; dstE[slo] = 2 * pos; wE[slo] = __int_as_float(info.z);
        tokE[shi] = row; dstE[shi] = 2 * pos + 1; wE[shi] = __int_as_float(info.w); }
    __syncthreads();
}

__device__ __forceinline__ const LAS int* moe_tile_table(const Frame& F0, const Params& p, int expert_table) {
    const Frame F = phase_frame(F0.lds);
    LAS int* lt = (LAS int*)(F.lds + LDS_MISC);
    const int* tile = (const int*)(p.ws + WS_TILE + (expert_table ? 4096 : 0));
    __syncthreads();
    for (int i = F.tid; i < 16 + SLOTSE_MAX / 256; i += NTHR) lt[i] = tile[i];
    __syncthreads();
    return lt;
}

template <bool CTX>
__device__ __forceinline__ void conv31_unit(const Frame& F, const bf16_t* Z, bf16_t* A2, int unit, int next_unit, unsigned (&rin)[32], const f32x2 (&w)[31], f32x2 bias, f32x2 lg, f32x2 lb) {
    constexpr int NIN = CTX ? 62 : 32;
    f32x2 xin[NIN]; int tok0, tstride;
    if (CTX) { const int b = unit >> 3, p0 = (unit & 7) * 32; tok0 = T_LAT + b * LCTX + p0; tstride = 1;
#pragma unroll
        for (int j = 0; j < NIN; ++j) { const int pos = p0 - 15 + j; const unsigned v = (pos >= 0 && pos < LCTX) ? *(const unsigned*)(Z + (size_t)(tok0 - 15 + j) * D + 2 * F.tid) : 0u; xin[j] = (f32x2){bf_lo(v), bf_hi(v)}; }
    } else { const int b = unit >> 6, col = unit & 63; tok0 = b * SEQ + col; tstride = 64;
#pragma unroll
        for (int j = 0; j < 32; ++j) xin[j] = (f32x2){bf_lo(rin[j]), bf_hi(rin[j])};
        if (next_unit >= 0) { const int nb = next_unit >> 6, ncol = next_unit & 63, ntok = nb * SEQ + ncol;
#pragma unroll
            for (int j = 0; j < 32; ++j) rin[j] = *(const unsigned*)(Z + (size_t)(ntok + j * 64) * D + 2 * F.tid); }
    }
    f32x2 o[32];
#pragma unroll
    for (int r = 0; r < 32; ++r) { f32x2 s = bias;
#pragma unroll
        for (int k = 0; k < 31; ++k) { const int j = CTX ? r + k : r + k - 15;
            if (j >= 0 && j < NIN) s += w[k] * xin[j]; }
        o[r] = s; }
    float v[64];
#pragma unroll
    for (int r = 0; r < 32; ++r) { v[r] = o[r].x + o[r].y; v[32 + r] = o[r].x * o[r].x + o[r].y * o[r].y; }
#pragma unroll
    for (int st = 32; st >= 1; st >>= 1) { const bool up = (F.lane & st) != 0;
#pragma unroll
        for (int i = 0; i < st; ++i) { const float mine = up ? v[st + i] : v[i], other = up ? v[i] : v[st + i]; v[i] = mine + __shfl_xor(other, st); } }
    LAS float* red = (LAS float*)F.lds;
    LAS float* stat = (LAS float*)(F.lds + 2048);
    __syncthreads();
    red[F.wave * 64 + F.lane] = v[0];
    __syncthreads();
    if (F.tid < 64) { float s = 0.f;
#pragma unroll
        for (int wv = 0; wv < 8; ++wv) s += red[wv * 64 + F.tid];
        stat[F.tid] = s * (1.0f / D); }
    __syncthreads();
#pragma unroll
    for (int r = 0; r < 32; ++r) { const float mu = stat[r], var = stat[32 + r] - mu * mu, rstd = rsqrtf(var + 1e-5f);
        const float y0 = (o[r].x - mu) * rstd * lg.x + lb.x, y1 = (o[r].y - mu) * rstd * lg.y + lb.y;
        *(unsigned*)(A2 + (size_t)(tok0 + r * tstride) * D + 2 * F.tid) = cvt_pk_bf16(y0 * fast_sigmoid(y0), y1 * fast_sigmoid(y1)); }
}
__device__ __forceinline__ void conv31_phase(const Frame& F0, const Params& p, int j, bool with_ctx) {
    const Frame F = phase_frame(F0.lds);
    const bf16_t* Z = (const bf16_t*)(p.ws + WS_T1); bf16_t* A2 = (bf16_t*)(p.ws + WS_T3);
    f32x2 w[31];
#pragma unroll
    for (int k = 0; k < 31; ++k) w[k] = *(const f32x2*)(p.in[I_CDW] + ((size_t)j * 31 + k) * D + 2 * F.tid);
    const f32x2 bias = *(const f32x2*)(p.in[I_CDWB] + (size_t)j * D + 2 * F.tid), lg = *(const f32x2*)(p.in[I_CLNG] + (size_t)j * D + 2 * F.tid), lb = *(const f32x2*)(p.in[I_CLNB] + (size_t)j * D + 2 * F.tid);
    const int nlat = NB * 64, ntot = nlat + (with_ctx ? NB * 8 : 0);
    unsigned rin[32];
    { const int u0 = F.bid, b = u0 >> 6, col = u0 & 63, tok = b * SEQ + col;
#pragma unroll
      for (int jj = 0; jj < 32; ++jj) rin[jj] = *(const unsigned*)(Z + (size_t)(tok + jj * 64) * D + 2 * F.tid); }
    for (int u = F.bid; u < ntot; u += F.G) {
        const int un = u + F.G;
        if (u < nlat) conv31_unit<false>(F, Z, A2, u, un < nlat ? un : -1, rin, w, bias, lg, lb);
        else conv31_unit<true>(F, Z, A2, u - nlat, -1, rin, w, bias, lg, lb);
    }
    __syncthreads();
}

__device__ __forceinline__ void scpre_phase(const Frame& F0, const Params& p) {
    const Frame F = phase_frame(F0.lds);
    const bf16_t* P = (const bf16_t*)(p.ws + WS_T1); const bf16_t* GB = (const bf16_t*)(p.ws + WS_T2); bf16_t* A2 = (bf16_t*)(p.ws + WS_T3);
    const float* cw = p.in[I_SCONV];
    for (int e = F.bid * NTHR + F.tid; e < T_ALL * 128; e += F.G * NTHR) { const int row = e >> 7, ch = (e & 127) * 8;
        bool lv, rv; if (row < T_LAT) { lv = (row & 63) != 0; rv = (row & 63) != 63; } else { const int l = (row - T_LAT) & 255; lv = l != 0; rv = l != 255; }
        const u32x4 z = (u32x4){0u, 0u, 0u, 0u};
        const u32x4 pc = *(const u32x4*)(P + (size_t)row * D + ch), pl = lv ? *(const u32x4*)(P + (size_t)(row - 1) * D + ch) : z, pr = rv ? *(const u32x4*)(P + (size_t)(row + 1) * D + ch) : z;
        const u32x4 gb = *(const u32x4*)(GB + (size_t)row * D + ch);
        float o[8];
#pragma unroll
        for (int q = 0; q < 4; ++q) { const f32x2 w0 = *(const f32x2*)(cw + ch + 2 * q), w1 = *(const f32x2*)(cw + D + ch + 2 * q), w2 = *(const f32x2*)(cw + 2 * D + ch + 2 * q);
            o[2 * q] = bf_lo(gb[q]) * (w0.x * bf_lo(pl[q]) + w1.x * bf_lo(pc[q]) + w2.x * bf_lo(pr[q]));
            o[2 * q + 1] = bf_hi(gb[q]) * (w0.y * bf_hi(pl[q]) + w1.y * bf_hi(pc[q]) + w2.y * bf_hi(pr[q])); }
        u32x4 w; w.x = cvt_pk_bf16(o[0], o[1]); w.y = cvt_pk_bf16(o[2], o[3]); w.z = cvt_pk_bf16(o[4], o[5]); w.w = cvt_pk_bf16(o[6], o[7]);
        *(u32x4*)(A2 + (size_t)row * D + ch) = w; }
}

__device__ __forceinline__ void s5scan_phase(const Frame& F0, const Params& p) {
    const Frame F = phase_frame(F0.lds);
    const float* S = (const float*)(p.ws + WS_T2); bf16_t* AG = (bf16_t*)(p.ws + WS_T1); const f32x2* A32 = (const f32x2*)(p.ws + WS_A32);
    for (int idx = F.bid * NTHR + F.tid; idx < NB * 64 * 2 * 64; idx += F.G * NTHR) {
        const int pp = idx & 63, dir = (idx >> 6) & 1, g = (idx >> 7) & 63, b = idx >> 13;
        const f32x2 a = A32[(g * 2 + dir) * 64 + pp]; float hr = 0.f, hi = 0.f;
        const int col = dir * 128 + 2 * pp;
        for (int st = 0; st < 72; ++st) { int crow;
            if (st < 8) crow = 2048 + b * 8 + (dir ? 7 - st : st); else crow = b * 64 + (dir ? 71 - st : st - 8);
            const size_t ro = (size_t)g * NCHUNK + crow;
            *(unsigned*)(AG + ro * AGLD + 512 + col) = cvt_pk_bf16(hr, hi);
            const f32x2 s = *(const f32x2*)(S + ro * 256 + col);
            const float nr = a.x * hr - a.y * hi + s.x, ni = a.x * hi + a.y * hr + s.y; hr = nr; hi = ni; }
    }
}

__global__ void __launch_bounds__(NTHR, 2) mega(Params p) {
    extern __shared__ __attribute__((aligned(16))) unsigned char lds_raw[];
    Frame F; F.lds = (LAS unsigned char*)lds_raw; F.tid = threadIdx.x; F.lane = F.tid & 63; F.wave = __builtin_amdgcn_readfirstlane(F.tid >> 6); F.G = gridDim.x; F.bid = blockIdx.x;
    unsigned char* ws = p.ws;
#if MK_ONE_LAUNCH
    if (F.tid < 4) ((LAS unsigned*)(F.lds + LDS_BARW))[F.tid] = 0u;
    __syncthreads();
    XcdBarrier bar = xcd_barrier_post((unsigned*)(ws + WS_CTL), (volatile LAS unsigned*)(F.lds + LDS_BARW));
#define GRID_BAR() xcd_barrier(bar)
#else
#define GRID_BAR() do {} while (0)
#endif
    const int lo = p.ph_lo, hi = p.ph_hi;
#ifndef PH_MASK
#define PH_MASK 0xFFFFFFFFu
#endif
#define EN(b) ((PH_MASK >> (b)) & 1u)
#ifndef REP_K2
#define REP_K2 0
#endif
#ifndef REP_MASK
#define REP_MASK 0u
#endif
#define NREP(b) (((REP_MASK >> (b)) & 1u) ? 2 : 1)
#define XSEL(b) ((rep + 1 < NREP(b)) ? X2 : X)
#define IN(k) (lo <= (k) && (k) < hi)
#define SEAM(k) do { if (IN(k) && IN((k) + 1)) GRID_BAR(); } while (0)
    bf16_t* X = (bf16_t*)(ws + WS_X); bf16_t* X2 = (bf16_t*)(ws + WS_END); bf16_t* H = (bf16_t*)(ws + WS_H);
    bf16_t* T1 = (bf16_t*)(ws + WS_T1); bf16_t* T2 = (bf16_t*)(ws + WS_T2); bf16_t* A2 = (bf16_t*)(ws + WS_T3);
    const float* mod = (const float*)(ws + WS_MOD);
    const float* x_in = p.in[I_X]; const float* ctx_adj = p.in[I_CTX] - (size_t)T_LAT * D;

    if (EN(0) && IN(0)) for (int rep = 0; rep < NREP(0); ++rep) { prologue_phase(F, p); } SEAM(0);

#pragma unroll
    for (int layer = 0; layer < DEPTH; ++layer) {
        const int pb = 1 + layer * 10, kind = layer % 3, jj = layer / 3;
        const bool upd = layer < DEPTH - 1; const int M = upd ? T_ALL : T_LAT;
        const float* ml = mod + (size_t)layer * NMOD * MODW;
        const bf16_t* mg16 = (const bf16_t*)(ws + WS_MODG) + (size_t)layer * 2 * NMOD * D;
        if (kind == 0) {
            if (EN(1) && IN(pb + 0)) for (int rep = 0; rep < NREP(1); ++rep) { if (layer == 0) norm_phase<0, true>(F, p, x_in, ctx_adj, X, M, p.in[I_N1G] + layer * D, ml + D, ml, layer, nullptr);
                else norm_phase<0, false>(F, p, x_in, ctx_adj, X, M, p.in[I_N1G] + layer * D, ml + D, ml, layer, nullptr); }
            SEAM(pb + 0);
            if (EN(3) && IN(pb + 1)) for (int rep = 0; rep < NREP(3); ++rep) { pg8::DenseOrder S; S.init(H, ws + WS_WCIN + (size_t)jj * 2048 * 1024 * 2, M, 2048, D, D, 1, 0, 0, F.G, F.bid); S.same = (REP_K2 == 2 && rep + 1 < NREP(3)) ? 1 : 0;
                pg8::EpiGlu E{T1}; pg8::gemm_phase(F.lds, pg8::GemmDesc{D, D, (REP_K2 == 1 && rep + 1 < NREP(3)) ? 2 * D : D, 1 << 20}, S, E); }
            SEAM(pb + 1);
            if (EN(4) && IN(pb + 2)) for (int rep = 0; rep < NREP(4); ++rep) conv31_phase(F, p, jj, upd);
            SEAM(pb + 2);
            if (EN(5) && IN(pb + 3)) for (int rep = 0; rep < NREP(5); ++rep) { pg8::DenseOrder S; S.init(A2, ws + WS_WCOUT + (size_t)jj * 1024 * 1024 * 2, M, 1024, D, D, 1, 0, 0, F.G, F.bid);
                if (layer == 0) { pg8::EpiResid<true> E{x_in, ctx_adj, XSEL(5), mg16}; pg8::gemm_phase(F.lds, pg8::GemmDesc{D, D, D, 1 << 20}, S, E); }
                else { pg8::EpiResid<false> E{x_in, ctx_adj, XSEL(5), mg16}; pg8::gemm_phase(F.lds, pg8::GemmDesc{D, D, D, 1 << 20}, S, E); } }
            SEAM(pb + 3);
        } else if (kind == 1) {
            if (EN(1) && IN(pb + 0)) for (int rep = 0; rep < NREP(1); ++rep) norm_phase<0, false>(F, p, x_in, ctx_adj, X, M, p.in[I_N1G] + layer * D, ml + D, ml, layer, nullptr);
            SEAM(pb + 0);
            if (EN(6) && IN(pb + 1)) for (int rep = 0; rep < NREP(6); ++rep) { pg8::DenseOrder S; S.init(H, ws + WS_WSIN, M, 3072, D, D, 1, 0, 0, F.G, F.bid);
                pg8::EpiSc E{T1, T2}; pg8::gemm_phase(F.lds, pg8::GemmDesc{D, D, D, 1 << 20}, S, E); }
            SEAM(pb + 1);
            if (EN(7) && IN(pb + 2)) for (int rep = 0; rep < NREP(7); ++rep) scpre_phase(F, p);
            SEAM(pb + 2);
            if (EN(8) && IN(pb + 3)) for (int rep = 0; rep < NREP(8); ++rep) { pg8::DenseOrder S; S.init(A2, ws + WS_WSOUT, M, 1024, D, D, 1, 0, 0, F.G, F.bid);
                pg8::EpiResid<false> E{x_in, ctx_adj, XSEL(8), mg16}; pg8::gemm_phase(F.lds, pg8::GemmDesc{D, D, D, 1 << 20}, S, E); }
            SEAM(pb + 3);
        } else {
            if (EN(2) && IN(pb + 0)) for (int rep = 0; rep < NREP(2); ++rep) norm_phase<1, false>(F, p, x_in, ctx_adj, X, M, p.in[I_N1G] + layer * D, ml + D, ml, layer, nullptr);
            SEAM(pb + 0);
            if (EN(9) && IN(pb + 1)) for (int rep = 0; rep < NREP(9); ++rep) { pg8::DenseOrder S; S.init(T1, ws + WS_S5WS, NCHUNK, 256, AGLD, 512, 64, (size_t)NCHUNK * AGLD * 2, (size_t)256 * 512 * 2, F.G, F.bid);
                pg8::EpiS5State E{(float*)T2}; pg8::gemm_phase(F.lds, pg8::GemmDesc{AGLD, 512, 512, 1 << 20}, S, E); }
            SEAM(pb + 1);
            if (EN(10) && IN(pb + 2)) for (int rep = 0; rep < NREP(10); ++rep) s5scan_phase(F, p);
            SEAM(pb + 2);
            if (EN(11) && IN(pb + 3)) for (int rep = 0; rep < NREP(11); ++rep) { pg8::DenseOrder S; S.init(T1, ws + WS_S5WT, NCHUNK, 512, AGLD, AGLD, 64, (size_t)NCHUNK * AGLD * 2, (size_t)512 * AGLD * 2, F.G, F.bid);
                pg8::EpiS5Out E{A2, T1, p.in[I_S5D]}; pg8::gemm_phase(F.lds, pg8::GemmDesc{AGLD, AGLD, AGLD, 1 << 20}, S, E); }
            SEAM(pb + 3);
            if (EN(12) && IN(pb + 4)) for (int rep = 0; rep < NREP(12); ++rep) { pg8::DenseOrder S; S.init(A2, ws + WS_WGLU, M, 2048, D, D, 1, 0, 0, F.G, F.bid);
                pg8::EpiGluResid E{XSEL(12), mg16}; pg8::gemm_phase(F.lds, pg8::GemmDesc{D, D, D, 1 << 20}, S, E); }
            SEAM(pb + 4);
        }
        if (EN(13) && IN(pb + 5)) for (int rep = 0; rep < NREP(13); ++rep) norm_phase<2, false>(F, p, x_in, ctx_adj, X, M, p.in[I_N2G] + layer * D, ml + 4 * D, ml + 3 * D, layer, nullptr);
        SEAM(pb + 5);
        if (EN(14) && IN(pb + 6)) for (int rep = 0; rep < NREP(14); ++rep) dispatch_phase(F, p, M);
        SEAM(pb + 6);
        if (EN(15) && IN(pb + 7)) for (int rep = 0; rep < NREP(15); ++rep) { const LAS int* lt = moe_tile_table(F, p, 1); pg8::MoeOrder<1> S; S.init(H, ws + WS_W13 + (size_t)layer * 32 * 1024 * 1024 * 2, lt, (const int*)(ws + WS_TOKE), F.G, F.bid);
            pg8::EpiSwiglu E{T2, (const int*)(ws + WS_DSTE), (const float*)(ws + WS_WE)}; pg8::gemm_phase(F.lds, pg8::GemmDesc{D, D, D, 1 << 20}, S, E); }
        SEAM(pb + 7);
        if (EN(16) && IN(pb + 8)) for (int rep = 0; rep < NREP(16); ++rep) { const LAS int* lt = moe_tile_table(F, p, 0); pg8::MoeOrder<2> S; S.init(T2, ws + WS_W2 + (size_t)layer * 32 * 1024 * 512 * 2, lt, (const int*)(ws + WS_PERM), F.G, F.bid);
            pg8::EpiMoeDown E{XSEL(16), (const int*)(ws + WS_PERM), mg16 + (size_t)NMOD * D}; pg8::gemm_phase(F.lds, pg8::GemmDesc{D, 512, D, 8}, S, E); }
        SEAM(pb + 8);
    }
    if (EN(17) && IN(41)) norm_phase<3, false>(F, p, x_in, ctx_adj, X, T_LAT, p.in[I_FG], nullptr, nullptr, 0, p.out);
#undef IN
#undef EN
#undef SEAM
}

extern "C" void kernel_launch(void* const* d_in, const int* in_sizes, int n_in, void* d_out, int out_size, void* d_ws, size_t ws_size, hipStream_t stream) {
    static int ready = 0;
    if (ready == 0) {
        if (n_in != 33 || out_size != T_LAT * D || ws_size < WS_END + (REP_MASK ? (size_t)T_ALL * D * 2 : 0)) { fprintf(stderr, "kernel_launch: unexpected shapes (n_in %d out %d ws %zu need %zu)\n", n_in, out_size, ws_size, (size_t)WS_END); ready = -1; return; }
        if (hipFuncSetAttribute((const void*)mega, hipFuncAttributeMaxDynamicSharedMemorySize, LDS_BYTES) != hipSuccess) { fprintf(stderr, "kernel_launch: hipFuncSetAttribute failed\n"); ready = -1; return; }
        int per_cu = 0; (void)hipOccupancyMaxActiveBlocksPerMultiprocessor(&per_cu, (const void*)mega, NTHR, LDS_BYTES); (void)hipGetLastError();
        if (per_cu < 1) fprintf(stderr, "kernel_launch: occupancy query reports %d\n", per_cu);
        ready = 1;
    }
    if (ready < 0) return;
    (void)hipMemsetAsync((char*)d_ws + WS_CTL, 0, CTL_BYTES, stream);
    Params p{};
    for (int i = 0; i < 33; ++i) p.in[i] = (const float*)d_in[i];
    p.out = (float*)d_out; p.ws = (unsigned char*)d_ws;
#if MK_ONE_LAUNCH
    p.ph_lo = 0; p.ph_hi = 42;
    hipLaunchKernelGGL(mega, dim3(NWG), dim3(NTHR), LDS_BYTES, stream, p);
#else
    for (int ph = 0; ph < 42; ++ph) {
        const int l = (ph - 1) / 10, k = (ph - 1) % 10;
        if (ph >= 1 && ph <= 40) { const int kind = l % 3; if (k == 9 || (kind != 2 && k == 4)) continue; }
        p.ph_lo = ph; p.ph_hi = ph + 1;
        hipLaunchKernelGGL(mega, dim3(NWG), dim3(NTHR), LDS_BYTES, stream, p);
    }
#endif
}
```
